# Optimizing an MI355X kernel written in HIP

```python
import jax
import jax.numpy as jnp
from jax import lax
import numpy as np

D_MODEL = 1024
BATCH = 4
SEQ = 8192
DEPTH = 2

GRID_W = 64
CTX_LEN = 256
HEAD_DIM = 64
ROPE_BASE = 10000.0
EPS = 1e-6
NEG_INF = -1e30
Q_BLOCK = 128

MLA_HEADS = 8
MLA_NOPE = 64
MLA_ROPE = 32
MLA_V = 64
MLA_Q_RANK = 256
MLA_KV_RANK = 128
MLA_IN = MLA_Q_RANK + MLA_KV_RANK + MLA_ROPE

NA_HEADS = 8
NA_KR_MAX = 8
NA_KC = 16
NA_CB = 16
NA_KB = 2 * NA_KC

SWA_HEADS = 16
SWA_KV_HEADS = 2
SWA_WINDOW = 128
SWA_BLOCK = 128

D_FF = (-(-8 * D_MODEL // 3) + 255) // 256 * 256

EVEN_IN = MLA_IN + 3 * NA_HEADS * HEAD_DIM
EVEN_OUT = MLA_HEADS * MLA_V + NA_HEADS * HEAD_DIM
ODD_IN = (SWA_HEADS + 2 * SWA_KV_HEADS) * HEAD_DIM
ODD_OUT = SWA_HEADS * HEAD_DIM
N_EVEN = (DEPTH + 1) // 2
N_ODD = DEPTH // 2

kernel_name = 'hybrid_mla_natten_swa_dit'


def rms_norm(x, gain=None):
    xf = x.astype(jnp.float32)
    y = xf * lax.rsqrt(jnp.mean(xf * xf, axis=-1, keepdims=True) + EPS)
    if gain is not None:
        y = y * gain.astype(jnp.float32)
    return y.astype(x.dtype)


def modulate(x, shift, scale):
    return rms_norm(x) * (1 + scale) + shift


def axial_rope(x, rows, cols):
    half = x.shape[-1] // 2
    inv = ROPE_BASE ** (-jnp.arange(0, half, 2, dtype=jnp.float32) / half)

    def rot(xa, pos):
        ang = pos.astype(jnp.float32)[:, None] * inv
        cos = jnp.cos(ang)[None, :, None, :]
        sin = jnp.sin(ang)[None, :, None, :]
        x1, x2 = jnp.split(xa.astype(jnp.float32), 2, axis=-1)
        return jnp.concatenate([x1 * cos - x2 * sin, x1 * sin + x2 * cos], axis=-1)

    xr, xc = jnp.split(x, 2, axis=-1)
    return jnp.concatenate([rot(xr, rows), rot(xc, cols)], axis=-1).astype(x.dtype)


def swiglu(h, w_gate_up, w_down):
    g, u = jnp.split(h @ w_gate_up, 2, axis=-1)
    return (jax.nn.silu(g) * u) @ w_down


def mla_heads(p_lat, p_ctx, rows, cols, q_norm, kv_norm, w_q_up, w_uk, w_uv, ctx_out):
    b, s = p_lat.shape[:2]
    n_ctx = p_ctx.shape[1]
    scale = (MLA_NOPE + MLA_ROPE) ** -0.5

    def queries(p, rotate):
        q = rms_norm(p[..., :MLA_Q_RANK], q_norm) @ w_q_up
        q = q.reshape(p.shape[0], p.shape[1], MLA_HEADS, MLA_NOPE + MLA_ROPE)
        q_nope, q_rope = q[..., :MLA_NOPE], q[..., MLA_NOPE:]
        if rotate:
            q_rope = axial_rope(q_rope, rows, cols)
        return jnp.einsum('bshn,hcn->bshc', q_nope, w_uk), q_rope

    def keys(p, rotate):
        c_kv = rms_norm(p[..., MLA_Q_RANK:MLA_Q_RANK + MLA_KV_RANK], kv_norm)
        k_rope = p[..., MLA_Q_RANK + MLA_KV_RANK:][:, :, None, :]
        if rotate:
            k_rope = axial_rope(k_rope, rows, cols)
        return c_kv, k_rope[:, :, 0]

    def attend(q_lat, q_rope, c_kv, k_rope):
        sc = jnp.einsum('bqhc,bkc->bhqk', q_lat, c_kv) + jnp.einsum('bqhr,bkr->bhqk', q_rope, k_rope)
        p = jax.nn.softmax(sc.astype(jnp.float32) * scale, axis=-1).astype(c_kv.dtype)
        return jnp.einsum('bhqk,bkc->bqhc', p, c_kv)

    ckv_c, kr_c = keys(p_ctx, False)
    ckv_l, kr_l = keys(p_lat, True)
    ckv_all = jnp.concatenate([ckv_c, ckv_l], axis=1)
    kr_all = jnp.concatenate([kr_c, kr_l], axis=1)
    ql, qr = queries(p_lat, True)
    nb = s // Q_BLOCK

    def to_blocks(t):
        return t.reshape(b, nb, Q_BLOCK, *t.shape[2:]).swapaxes(0, 1)

    o = lax.map(lambda a: attend(a[0], a[1], ckv_all, kr_all), (to_blocks(ql), to_blocks(qr)))
    o = o.swapaxes(0, 1).reshape(b, s, MLA_HEADS, MLA_KV_RANK)
    o_lat = jnp.einsum('bshc,hcv->bshv', o, w_uv).reshape(b, s, MLA_HEADS * MLA_V)
    o_ctx = None
    if ctx_out:
        qlc, qrc = queries(p_ctx, False)
        oc = attend(qlc, qrc, ckv_c, kr_c)
        o_ctx = jnp.einsum('bshc,hcv->bshv', oc, w_uv).reshape(b, n_ctx, MLA_HEADS * MLA_V)
    return o_lat, o_ctx


def na_heads(q, k, v, qc, kc, vc, rel_bias, ctx_out):
    b, s, h, d = q.shape
    n_ctx = kc.shape[1]
    n_rows = s // GRID_W
    kr = min(NA_KR_MAX, n_rows)
    n_cb = GRID_W // NA_CB
    scale = d ** -0.5
    qcol = np.arange(GRID_W).reshape(n_cb, NA_CB)
    q_start = np.clip(qcol - NA_KC // 2, 0, GRID_W - NA_KC)
    kb_start = np.clip(np.arange(n_cb) * NA_CB - NA_KC // 2, 0, GRID_W - NA_KB)
    kcol = kb_start[:, None] + np.arange(NA_KB)
    col_ok = (kcol[:, None, :] >= q_start[..., None]) & (kcol[:, None, :] < q_start[..., None] + NA_KC)
    dc_idx = np.clip(kcol[:, None, :] - qcol[..., None] + NA_KC - 1, 0, 2 * NA_KC - 2)
    col_bias = rel_bias[:, :, dc_idx].astype(jnp.float32)
    kg = k.reshape(b, n_rows, GRID_W, h, d)
    vg = v.reshape(b, n_rows, GRID_W, h, d)
    q_rows = q.reshape(b, n_rows, n_cb, NA_CB, h, d).swapaxes(0, 1)

    def row(args):
        r, qr = args
        rs = jnp.clip(r - kr // 2, 0, n_rows - kr)
        k_blk = lax.dynamic_slice_in_dim(kg, rs, kr, axis=1)[:, :, kcol]
        v_blk = lax.dynamic_slice_in_dim(vg, rs, kr, axis=1)[:, :, kcol]
        s_lat = jnp.einsum('bnqhd,bknmhd->bhnqkm', qr, k_blk).astype(jnp.float32) * scale
        dr_idx = rs + jnp.arange(kr) - r + NA_KR_MAX - 1
        s_lat = s_lat + col_bias[:, dr_idx].transpose(0, 2, 3, 1, 4)[None]
        s_lat = jnp.where(col_ok[:, :, None, :], s_lat, NEG_INF).reshape(b, h, n_cb, NA_CB, kr * NA_KB)
        s_ctx = jnp.einsum('bnqhd,bchd->bhnqc', qr, kc).astype(jnp.float32) * scale
        p = jax.nn.softmax(jnp.concatenate([s_ctx, s_lat], axis=-1), axis=-1).astype(v.dtype)
        p_lat = p[..., n_ctx:].reshape(b, h, n_cb, NA_CB, kr, NA_KB)
        return (jnp.einsum('bhnqc,bchd->bnqhd', p[..., :n_ctx], vc)
                + jnp.einsum('bhnqkm,bknmhd->bnqhd', p_lat, v_blk))

    o = lax.map(row, (jnp.arange(n_rows), q_rows))
    o_lat = o.swapaxes(0, 1).reshape(b, s, h * d)
    o_ctx = None
    if ctx_out:
        sc = jnp.einsum('bqhd,bkhd->bhqk', qc, kc).astype(jnp.float32) * scale
        pc = jax.nn.softmax(sc, axis=-1).astype(vc.dtype)
        o_ctx = jnp.einsum('bhqk,bkhd->bqhd', pc, vc).reshape(b, n_ctx, h * d)
    return o_lat, o_ctx


def swa_heads(q, k, v, qc, kc, vc, sinks, ctx_out):
    b, s, h, d = q.shape
    kvh = k.shape[2]
    g = h // kvh
    n_ctx = kc.shape[1]
    scale = d ** -0.5
    nb = s // SWA_BLOCK
    n_side = -(-SWA_WINDOW // SWA_BLOCK)
    pad = n_side * SWA_BLOCK
    kw = (2 * n_side + 1) * SWA_BLOCK

    def windows(t):
        tp = jnp.pad(t, ((0, 0), (pad, pad), (0, 0), (0, 0))).reshape(b, nb + 2 * n_side, SWA_BLOCK, kvh, d)
        return jnp.concatenate([tp[:, j:j + nb] for j in range(2 * n_side + 1)], axis=2).swapaxes(0, 1)

    q_pos = jnp.arange(s).reshape(nb, SWA_BLOCK)
    k_pos = (jnp.arange(nb)[:, None] - n_side) * SWA_BLOCK + jnp.arange(kw)[None, :]
    sink_col = sinks.astype(jnp.float32).reshape(kvh, g, 1, 1)

    def attend(qb, kb, vb, band_ok):
        tq = qb.shape[1]
        qg = qb.reshape(b, tq, kvh, g, d)
        s_ctx = jnp.einsum('bqkgd,bckd->bkgqc', qg, kc).astype(jnp.float32) * scale
        parts = [jnp.broadcast_to(sink_col, (b, kvh, g, tq, 1)), s_ctx]
        if kb is not None:
            s_lat = jnp.einsum('bqkgd,bmkd->bkgqm', qg, kb).astype(jnp.float32) * scale
            parts.append(jnp.where(band_ok, s_lat, NEG_INF))
        p = jax.nn.softmax(jnp.concatenate(parts, axis=-1), axis=-1).astype(vc.dtype)
        o = jnp.einsum('bkgqc,bckd->bqkgd', p[..., 1:1 + n_ctx], vc)
        if kb is not None:
            o = o + jnp.einsum('bkgqm,bmkd->bqkgd', p[..., 1 + n_ctx:], vb)
        return o.reshape(b, tq, h * d)

    def block(args):
        qb, kb, vb, qp, kp = args
        ok = (jnp.abs(kp[None, :] - qp[:, None]) <= SWA_WINDOW) & (kp >= 0)[None, :] & (kp < s)[None, :]
        return attend(qb, kb, vb, ok)

    q_blocks = q.reshape(b, nb, SWA_BLOCK, h, d).swapaxes(0, 1)
    o = lax.map(block, (q_blocks, windows(k), windows(v), q_pos, k_pos))
    o_lat = o.swapaxes(0, 1).reshape(b, s, h * d)
    o_ctx = attend(qc, None, None, None) if ctx_out else None
    return o_lat, o_ctx


def even_mixer(a_lat, a_ctx, rows, cols, w_in, q_norm, kv_norm, w_q_up, w_uk, w_uv, rel_bias, w_out, ctx_out):
    b, s, _ = a_lat.shape
    n_ctx = a_ctx.shape[1]
    p_lat = a_lat @ w_in
    p_ctx = a_ctx @ w_in
    o_mla_lat, o_mla_ctx = mla_heads(p_lat[..., :MLA_IN], p_ctx[..., :MLA_IN], rows, cols,
                                     q_norm, kv_norm, w_q_up, w_uk, w_uv, ctx_out)
    na_l = p_lat[..., MLA_IN:].reshape(b, s, 3, NA_HEADS, HEAD_DIM)
    na_c = p_ctx[..., MLA_IN:].reshape(b, n_ctx, 3, NA_HEADS, HEAD_DIM)
    o_na_lat, o_na_ctx = na_heads(na_l[:, :, 0], na_l[:, :, 1], na_l[:, :, 2],
                                  na_c[:, :, 0], na_c[:, :, 1], na_c[:, :, 2], rel_bias, ctx_out)
    o_lat = jnp.concatenate([o_mla_lat, o_na_lat], axis=-1) @ w_out
    o_ctx = jnp.concatenate([o_mla_ctx, o_na_ctx], axis=-1) @ w_out if ctx_out else None
    return o_lat, o_ctx


def odd_mixer(a_lat, a_ctx, rows, cols, w_in, sinks, w_out, ctx_out):
    b, s, _ = a_lat.shape
    n_ctx = a_ctx.shape[1]

    def split(p, t):
        q = p[..., :SWA_HEADS * HEAD_DIM].reshape(b, t, SWA_HEADS, HEAD_DIM)
        kv = p[..., SWA_HEADS * HEAD_DIM:].reshape(b, t, 2, SWA_KV_HEADS, HEAD_DIM)
        return q, kv[:, :, 0], kv[:, :, 1]

    q, k, v = split(a_lat @ w_in, s)
    q = axial_rope(q, rows, cols)
    k = axial_rope(k, rows, cols)
    qc, kc, vc = split(a_ctx @ w_in, n_ctx)
    o_lat, o_ctx = swa_heads(q, k, v, qc, kc, vc, sinks, ctx_out)
    return o_lat @ w_out, (o_ctx @ w_out if ctx_out else None)


def setup_inputs(seed: int = 0) -> dict:
    key = jax.random.key(seed)
    ks = jax.random.split(key, 20)
    nrm = jax.random.normal
    f32 = jnp.float32
    return {
        'x': nrm(ks[0], (BATCH, SEQ, D_MODEL), f32),
        'c': nrm(ks[1], (BATCH, D_MODEL), f32),
        'ctx': nrm(ks[2], (BATCH, CTX_LEN, D_MODEL), f32),
        'c_ctx': nrm(ks[3], (D_MODEL,), f32),
        'mod_w': nrm(ks[4], (DEPTH, D_MODEL, 6 * D_MODEL), f32) * (0.5 * D_MODEL ** -0.5),
        'mod_b': nrm(ks[5], (DEPTH, 6 * D_MODEL), f32) * 0.02,
        'even_w_in': nrm(ks[6], (N_EVEN, D_MODEL, EVEN_IN), f32) * D_MODEL ** -0.5,
        'mla_q_norm': 1.0 + 0.02 * nrm(ks[7], (N_EVEN, MLA_Q_RANK), f32),
        'mla_kv_norm': 1.0 + 0.02 * nrm(ks[8], (N_EVEN, MLA_KV_RANK), f32),
        'mla_w_q_up': nrm(ks[9], (N_EVEN, MLA_Q_RANK, MLA_HEADS * (MLA_NOPE + MLA_ROPE)), f32) * MLA_Q_RANK ** -0.5,
        'mla_w_uk': nrm(ks[10], (N_EVEN, MLA_HEADS, MLA_KV_RANK, MLA_NOPE), f32) * MLA_NOPE ** -0.5,
        'mla_w_uv': nrm(ks[11], (N_EVEN, MLA_HEADS, MLA_KV_RANK, MLA_V), f32) * MLA_KV_RANK ** -0.5,
        'na_rel_bias': 0.2 * nrm(ks[12], (N_EVEN, NA_HEADS, 2 * NA_KR_MAX - 1, 2 * NA_KC - 1), f32),
        'even_w_out': nrm(ks[13], (N_EVEN, EVEN_OUT, D_MODEL), f32) * EVEN_OUT ** -0.5,
        'odd_w_in': nrm(ks[14], (N_ODD, D_MODEL, ODD_IN), f32) * D_MODEL ** -0.5,
        'swa_sinks': nrm(ks[15], (N_ODD, SWA_HEADS), f32),
        'odd_w_out': nrm(ks[16], (N_ODD, ODD_OUT, D_MODEL), f32) * ODD_OUT ** -0.5,
        'ffn_w_gate_up': nrm(ks[17], (DEPTH, D_MODEL, 2 * D_FF), f32) * D_MODEL ** -0.5,
        'ffn_w_down': nrm(ks[18], (DEPTH, D_FF, D_MODEL), f32) * D_FF ** -0.5,
        'final_norm': 1.0 + 0.02 * nrm(ks[19], (D_MODEL,), f32),
    }


def reference(x, c, ctx, c_ctx, mod_w, mod_b, even_w_in, mla_q_norm, mla_kv_norm, mla_w_q_up, mla_w_uk,
              mla_w_uv, na_rel_bias, even_w_out, odd_w_in, swa_sinks, odd_w_out, ffn_w_gate_up, ffn_w_down,
              final_norm):
    s = x.shape[1]
    t = jnp.arange(s, dtype=jnp.int32)
    rows, cols = t // GRID_W, t % GRID_W
    h_lat, h_ctx = x, ctx
    silu_c = jax.nn.silu(c)[:, None, :]
    silu_cc = jax.nn.silu(c_ctx)[None, None, :]
    for l in range(DEPTH):
        ctx_out = l < DEPTH - 1
        sh_a, sc_a, g_a, sh_f, sc_f, g_f = jnp.split(silu_c @ mod_w[l] + mod_b[l], 6, axis=-1)
        csh_a, csc_a, cg_a, csh_f, csc_f, cg_f = jnp.split(silu_cc @ mod_w[l] + mod_b[l], 6, axis=-1)
        a_lat = modulate(h_lat, sh_a, sc_a)
        a_ctx = modulate(h_ctx, csh_a, csc_a)
        if l % 2 == 0:
            e = l // 2
            o_lat, o_ctx = even_mixer(a_lat, a_ctx, rows, cols, even_w_in[e], mla_q_norm[e], mla_kv_norm[e],
                                      mla_w_q_up[e], mla_w_uk[e], mla_w_uv[e], na_rel_bias[e], even_w_out[e],
                                      ctx_out)
        else:
            o = l // 2
            o_lat, o_ctx = odd_mixer(a_lat, a_ctx, rows, cols, odd_w_in[o], swa_sinks[o], odd_w_out[o], ctx_out)
        h_lat = h_lat + g_a * o_lat
        h_lat = h_lat + g_f * swiglu(modulate(h_lat, sh_f, sc_f), ffn_w_gate_up[l], ffn_w_down[l])
        if ctx_out:
            h_ctx = h_ctx + cg_a * o_ctx
            h_ctx = h_ctx + cg_f * swiglu(modulate(h_ctx, csh_f, csc_f), ffn_w_gate_up[l], ffn_w_down[l])
    return rms_norm(h_lat, final_norm)
```

```cpp
#include <hip/hip_runtime.h>
#include <hip/hip_cooperative_groups.h>
#include <cstdio>
namespace cg = cooperative_groups;

#define DI __device__ __forceinline__
typedef unsigned short bf16_t;
typedef short bf16x8 __attribute__((ext_vector_type(8)));
typedef short s16x4 __attribute__((ext_vector_type(4)));
typedef float f32x2 __attribute__((ext_vector_type(2)));
typedef float f32x4 __attribute__((ext_vector_type(4)));
typedef float f32x16 __attribute__((ext_vector_type(16)));
typedef __bf16 bf16x2_t __attribute__((ext_vector_type(2)));
typedef unsigned u32x2 __attribute__((ext_vector_type(2)));
typedef unsigned u32x4 __attribute__((ext_vector_type(4)));
#define LAS __attribute__((address_space(3)))

DI int opq_v(int x) { asm volatile("" : "+v"(x)); return x; }
DI int opq_s(int x) { asm volatile("" : "+s"(x)); return x; }
#define PHASE_IDS const int tid = opq_v((opq_s(wid0) << 6) | (int)__builtin_amdgcn_mbcnt_hi((unsigned)opq_s(-1), __builtin_amdgcn_mbcnt_lo((unsigned)opq_s(-1), 0u))); const int bid = opq_s((int)blockIdx.x); const int nb = opq_s((int)gridDim.x); (void)tid; (void)bid; (void)nb
DI unsigned pk2(float a, float b) { f32x2 v = {a, b}; return __builtin_bit_cast(unsigned, __builtin_convertvector(v, bf16x2_t)); }
DI float bflo(unsigned u) { return __uint_as_float(u << 16); }
DI float bfhi(unsigned u) { return __uint_as_float(u & 0xffff0000u); }

constexpr int T_LAT = 32768, T_CTX = 1024, T_ALL = 33792, DM = 1024, SEQ = 8192, NCTX = 256, NKEY = 8448;
constexpr int DFF = 2816;
constexpr float EPS = 1e-6f, LOG2E = 1.4426950408889634f;

constexpr size_t MiB = 1u << 20;
constexpr size_t W_IN0 = 0, W_Q = 4 * MiB, W_KV = 4 * MiB + 384 * 1024, W_OUT0 = 5 * MiB, W_GU0 = 8 * MiB, W_GU1 = 19 * MiB, W_DN0 = 30 * MiB, W_DN1 = 36 * MiB,
                 W_IN1 = 42 * MiB, W_OUT1 = 45 * MiB;
constexpr size_t MISC = 47 * MiB;
constexpr size_t MISC_MODV = MISC;
constexpr size_t MISC_ROPEM = MISC + 256 * 1024;
constexpr size_t MISC_ROPES = MISC + 272 * 1024;
constexpr size_t MISC_BAR = MISC + 512 * 1024;
constexpr size_t H_OFF = 48 * MiB;
constexpr size_t QMLA_OFF = H_OFF;
constexpr size_t KVF_OFF = H_OFF + 50 * MiB;
constexpr size_t ATTO_OFF = 184 * MiB;
constexpr size_t QN_OFF = 412 * MiB;
constexpr size_t A2_OFF = 429 * MiB;
constexpr size_t A_OFF = 180 * MiB;
constexpr size_t S_OFF = 279 * MiB;
constexpr size_t O1_OFF = S_OFF + 83 * MiB;
constexpr size_t PART_OFF = 461 * MiB;
constexpr size_t WS_END = 505 * MiB;

struct Params {
  const float *x, *c, *ctx, *c_ctx, *mod_w, *mod_b, *even_w_in, *q_norm, *kv_norm, *w_q_up, *w_uk, *w_uv, *rel_bias, *even_w_out,
      *odd_w_in, *sinks, *odd_w_out, *w_gu, *w_dn, *final_norm;
  float* out;
  char* ws;
};

constexpr int BM = 256, BK = 64, HALF = 128, HT = HALF * BK, NXCD = 8, WGM = 8;
constexpr int GEMM_LDS = 8 * HT * 2;

DI int lds_byte(int r, int c) {
  int st = (r >> 4) * 2 + (c >> 5), rr = r & 15, cc = c & 31, ob = rr * 64 + cc * 2;
  return st * 1024 + (ob ^ (((ob >> 9) & 1) << 5));
}
DI void stage_rc(int b, int& R, int& C) {
  int st = b / 1024, sb = b % 1024, swz = sb ^ (((sb >> 9) & 1) << 5);
  R = (st >> 1) * 16 + swz / 64; C = (st & 1) * 32 + (swz % 64) / 2;
}

enum { EPI_BF16 = 0, EPI_ROPE_MLA = 1, EPI_ROPE_SWA = 2, EPI_RESID = 3, EPI_SWIGLU = 4, EPI_F32P = 5, EPI_KVF = 6 };
struct EpiArgs {
  void* out; int ldo;
  const float* hin_lat; const float* hin_ctx;
  const float* gate;
  const float* rope;
  float qscale; int qs_lo, qs_hi;
};

template <int EPI>
DI void gemm_phase(const bf16_t* __restrict__ A, const bf16_t* __restrict__ Bt, int M, int N, int K, const EpiArgs e, LAS unsigned char* lds, const int wid0, const int ksplit = 1) {
  PHASE_IDS;
  const int wid = __builtin_amdgcn_readfirstlane(tid >> 6), lane = tid & 63, wr = wid >> 2, wc = wid & 3, fr = lane & 15, fq = lane >> 4;
  const int kloop = K / ksplit;
  const int nt = kloop / BK;
  const int nM = M / BM, nN = N / BM, ntile = nM * nN, nwg = ntile * ksplit;
  unsigned voff[2];
#pragma unroll
  for (int i = 0; i < 2; ++i) { int R, C; stage_rc(tid * 16 + i * 8192, R, C); voff[i] = (unsigned)(R * K + C) * 2u; }
  const size_t kstep = (size_t)(BK * 2);
  const size_t hstep = (size_t)HALF * K * 2;
  const size_t tstep = 2 * hstep;
  const unsigned ldsw = (unsigned)wid * 1024u;
  const int aoff = lds_byte(wr * 64 + fr, fq * 8), boff = lds_byte(wc * 32 + fr, fq * 8);
  constexpr int HTB = HALF * BK * 2;
#define PG8_SA(b, h) (((b) * 2 + (h)) * HTB)
#define PG8_SB(b, h) ((4 + (b) * 2 + (h)) * HTB)
#define PG8_STAGE(bufoff, gbase) do { _Pragma("unroll") for (int _i = 0; _i < 2; ++_i) \
    __builtin_amdgcn_global_load_lds((const unsigned*)((const char*)(gbase) + voff[_i]), (LAS unsigned*)(lds + (bufoff) + ldsw + _i * 8192), 16, 0, 0); } while (0)
#define PG8_LDA(dst, b, h) do { _Pragma("unroll") for (int m = 0; m < 4; ++m) _Pragma("unroll") for (int k = 0; k < 2; ++k) dst[m][k] = *(const LAS bf16x8*)(lds + PG8_SA(b, h) + aoff + m * 2048 + k * 1024); } while (0)
#define PG8_LDB(dst, b, h) do { _Pragma("unroll") for (int n = 0; n < 2; ++n) _Pragma("unroll") for (int k = 0; k < 2; ++k) dst[n][k] = *(const LAS bf16x8*)(lds + PG8_SB(b, h) + boff + n * 2048 + k * 1024); } while (0)
#define PG8_MMA(ai, bj, At_, Bt_) do { __builtin_amdgcn_s_setprio(1); _Pragma("unroll") for (int m = 0; m < 4; ++m) _Pragma("unroll") for (int n = 0; n < 2; ++n) _Pragma("unroll") for (int k = 0; k < 2; ++k) \
    acc[ai][bj][m][n] = __builtin_amdgcn_mfma_f32_16x16x32_bf16(Bt_[n][k], At_[m][k], acc[ai][bj][m][n], 0, 0, 0); __builtin_amdgcn_s_setprio(0); } while (0)
#define PG8_WAIT_V(n) asm volatile("s_waitcnt vmcnt(" #n ")" ::: "memory")
#define PG8_WAIT_L(n) asm volatile("s_waitcnt lgkmcnt(" #n ")" ::: "memory")
#define PG8_BAR __builtin_amdgcn_s_barrier()
#define PG8_SCHED __builtin_amdgcn_sched_barrier(0)
#define UNIT_OF(L_, pm_, pn_, ks_) do { ks_ = (L_) / ntile; int wgid = (L_) - ks_ * ntile; { const int q = ntile / NXCD, r = ntile % NXCD, xcd = wgid % NXCD, off = wgid / NXCD; \
      wgid = (xcd < r ? xcd * (q + 1) : r * (q + 1) + (xcd - r) * q) + off; } \
    const int nig = WGM * nN, gid = wgid / nig, fm = gid * WGM, gsz = (nM - fm) < WGM ? (nM - fm) : WGM; \
    pm_ = fm + ((wgid % nig) % gsz); pn_ = (wgid % nig) / gsz; } while (0)

  int L = bid;
  if (L >= nwg) return;
  int pm, pn, ksu, npm = 0, npn = 0, nksu = 0;
  UNIT_OF(L, pm, pn, ksu);
  f32x4 acc[2][2][4][2];
#pragma unroll
  for (int a = 0; a < 2; ++a)
#pragma unroll
    for (int b = 0; b < 2; ++b)
#pragma unroll
      for (int m = 0; m < 4; ++m)
#pragma unroll
        for (int n = 0; n < 2; ++n) acc[a][b][m][n] = (f32x4){0.f, 0.f, 0.f, 0.f};
  bf16x8 At[4][2], B0[2][2], B1[2][2];
  const char* cA = (const char*)A + (size_t)pm * tstep + (size_t)ksu * kloop * 2; const char* cB = (const char*)Bt + (size_t)pn * tstep + (size_t)ksu * kloop * 2;
  PG8_STAGE(PG8_SB(0, 0), cB); PG8_STAGE(PG8_SA(0, 0), cA); PG8_STAGE(PG8_SB(0, 1), cB + hstep); PG8_STAGE(PG8_SA(0, 1), cA + hstep);
  if (wr == 1) PG8_BAR;
  PG8_WAIT_V(4); PG8_BAR;
  PG8_STAGE(PG8_SB(1, 0), cB + kstep); PG8_STAGE(PG8_SA(1, 0), cA + kstep); PG8_STAGE(PG8_SB(1, 1), cB + hstep + kstep);
  PG8_WAIT_V(6); PG8_BAR;
  for (;;) {
    const int Ln = L + nb;
    const bool has_next = Ln < nwg;
    if (has_next) UNIT_OF(Ln, npm, npn, nksu);
    const char* nA = has_next ? (const char*)A + (size_t)npm * tstep + (size_t)nksu * kloop * 2 : cA; const char* nB = has_next ? (const char*)Bt + (size_t)npn * tstep + (size_t)nksu * kloop * 2 : cB;
    for (int t = 0; t < nt; t += 2) {
      const bool last = (t == nt - 2);
      const char* a1 = cA + (size_t)(t + 1) * kstep;
      const char* a2 = last ? nA : cA + (size_t)(t + 2) * kstep; const char* b2 = last ? nB : cB + (size_t)(t + 2) * kstep;
      const char* a3 = a2 + kstep; const char* b3 = b2 + kstep;
      PG8_LDB(B0, 0, 0); PG8_SCHED; PG8_LDA(At, 0, 0); PG8_STAGE(PG8_SA(1, 1), a1 + hstep);
      PG8_WAIT_L(8); PG8_BAR; PG8_WAIT_L(0); PG8_MMA(0, 0, At, B0); PG8_BAR; PG8_SCHED;
      PG8_LDB(B1, 0, 1); PG8_STAGE(PG8_SB(0, 0), b2);
      PG8_BAR; PG8_WAIT_L(0); PG8_MMA(0, 1, At, B1); PG8_BAR;
      PG8_LDA(At, 0, 1); PG8_STAGE(PG8_SA(0, 0), a2);
      PG8_BAR; PG8_WAIT_L(0); PG8_MMA(1, 0, At, B0); PG8_BAR; PG8_SCHED;
      PG8_STAGE(PG8_SB(0, 1), b2 + hstep);
      PG8_WAIT_V(6); PG8_BAR; PG8_MMA(1, 1, At, B1); PG8_BAR;
      PG8_LDB(B0, 1, 0); PG8_SCHED; PG8_LDA(At, 1, 0); PG8_STAGE(PG8_SA(0, 1), a2 + hstep);
      PG8_WAIT_L(8); PG8_BAR; PG8_WAIT_L(0); PG8_MMA(0, 0, At, B0); PG8_BAR; PG8_SCHED;
      PG8_LDB(B1, 1, 1); PG8_STAGE(PG8_SB(1, 0), b3);
      PG8_BAR; PG8_WAIT_L(0); PG8_MMA(0, 1, At, B1); PG8_BAR;
      PG8_LDA(At, 1, 1); PG8_STAGE(PG8_SA(1, 0), a3);
      PG8_BAR; PG8_WAIT_L(0); PG8_MMA(1, 0, At, B0); PG8_BAR; PG8_SCHED;
      PG8_STAGE(PG8_SB(1, 1), b3 + hstep);
      PG8_WAIT_V(6); PG8_BAR; PG8_MMA(1, 1, At, B1); PG8_BAR;
    }
    const int brow = pm * BM, bcol = pn * BM;
#pragma unroll
    for (int ai = 0; ai < 2; ++ai)
#pragma unroll
      for (int m = 0; m < 4; ++m) {
        const int row = brow + ai * HALF + wr * 64 + m * 16 + fr;
#pragma unroll
        for (int bj = 0; bj < 2; ++bj) {
          const int gcol0 = bcol + bj * HALF + wc * 32;
          f32x4 v0 = acc[ai][bj][m][0], v1 = acc[ai][bj][m][1];
          if (EPI == EPI_KVF) {
            const int b = (row < T_LAT) ? (row >> 13) : ((row - T_LAT) >> 8);
            const int key = (row < T_LAT) ? (NCTX + (row & (SEQ - 1))) : ((row - T_LAT) & 255);
            int hd, within;
            if (gcol0 < 768) { hd = gcol0 / 96; within = gcol0 - hd * 96; } else { hd = (gcol0 - 768) >> 6; within = 96 + ((gcol0 - 768) & 63); }
            bf16_t* o = (bf16_t*)e.out + ((size_t)(b * 8 + hd) * NKEY + key) * 160 + within + 4 * fq;
            *(u32x2*)o = (u32x2){pk2(v0[0], v0[1]), pk2(v0[2], v0[3])};
            *(u32x2*)(o + 16) = (u32x2){pk2(v1[0], v1[1]), pk2(v1[2], v1[3])};
          } else
          if (EPI == EPI_F32P) {
            float* o = (float*)e.out + ((size_t)ksu * M + row) * N + gcol0 + 4 * fq;
            *(f32x4*)o = v0; *(f32x4*)(o + 16) = v1;
          } else
          if (EPI == EPI_BF16 || EPI == EPI_ROPE_MLA || EPI == EPI_ROPE_SWA) {
            if (EPI != EPI_BF16) {
              bool isrope; int usecol, f0, nf;
              if (EPI == EPI_ROPE_MLA) { isrope = ((gcol0 >> 5) % 3) == 2; usecol = fq >> 1; f0 = (4 * fq) & 7; nf = 8; }
              else { isrope = gcol0 < 1152; usecol = (gcol0 >> 5) & 1; f0 = 4 * fq; nf = 16; }
              if (isrope && row < T_LAT) {
                const int s = row & (SEQ - 1), pos = usecol ? (s & 63) : (s >> 6);
                const f32x4* tp = (const f32x4*)(e.rope + (size_t)(pos * nf + f0) * 2);
                const f32x4 c01 = tp[0], c23 = tp[1];
                f32x4 a0 = v0, a1 = v1;
                v0[0] = a0[0] * c01[0] - a1[0] * c01[1]; v1[0] = a0[0] * c01[1] + a1[0] * c01[0];
                v0[1] = a0[1] * c01[2] - a1[1] * c01[3]; v1[1] = a0[1] * c01[3] + a1[1] * c01[2];
                v0[2] = a0[2] * c23[0] - a1[2] * c23[1]; v1[2] = a0[2] * c23[1] + a1[2] * c23[0];
                v0[3] = a0[3] * c23[2] - a1[3] * c23[3]; v1[3] = a0[3] * c23[3] + a1[3] * c23[2];
              }
            }
            if (gcol0 >= e.qs_lo && gcol0 < e.qs_hi) { v0 *= e.qscale; v1 *= e.qscale; }
            bf16_t* o = (bf16_t*)e.out + (size_t)row * e.ldo + gcol0 + 4 * fq;
            *(u32x2*)o = (u32x2){pk2(v0[0], v0[1]), pk2(v0[2], v0[3])};
            *(u32x2*)(o + 16) = (u32x2){pk2(v1[0], v1[1]), pk2(v1[2], v1[3])};
          } else if (EPI == EPI_RESID) {
            const float* hin = (row < T_LAT) ? e.hin_lat + (size_t)row * DM : e.hin_ctx + (size_t)(row - T_LAT) * DM;
            const int bb = (row < T_LAT) ? (row >> 13) : 4;
            const float* g = e.gate + bb * 6144;
            const int c0 = gcol0 + 4 * fq;
            float* o = (float*)e.out + (size_t)row * DM;
            f32x4 h0 = *(const f32x4*)(hin + c0), h1 = *(const f32x4*)(hin + c0 + 16);
            f32x4 g0 = *(const f32x4*)(g + c0), g1 = *(const f32x4*)(g + c0 + 16);
            *(f32x4*)(o + c0) = h0 + g0 * v0;
            *(f32x4*)(o + c0 + 16) = h1 + g1 * v1;
          } else {
            f32x4 r;
#pragma unroll
            for (int i = 0; i < 4; ++i) { const float gq = v0[i]; r[i] = gq * __builtin_amdgcn_rcpf(1.f + __builtin_amdgcn_exp2f(-LOG2E * gq)) * v1[i]; }
            bf16_t* o = (bf16_t*)e.out + (size_t)row * e.ldo + (gcol0 >> 1) + 4 * fq;
            *(u32x2*)o = (u32x2){pk2(r[0], r[1]), pk2(r[2], r[3])};
          }
        }
      }
    if (!has_next) break;
#pragma unroll
    for (int a = 0; a < 2; ++a)
#pragma unroll
      for (int b = 0; b < 2; ++b)
#pragma unroll
        for (int m = 0; m < 4; ++m)
#pragma unroll
          for (int n = 0; n < 2; ++n) acc[a][b][m][n] = (f32x4){0.f, 0.f, 0.f, 0.f};
    L = Ln; pm = npm; pn = npn; ksu = nksu; cA = nA; cB = nB;
  }
  PG8_WAIT_V(0);
  if (wr == 0) PG8_BAR;
  PG8_BAR;
#undef PG8_SA
#undef PG8_SB
#undef PG8_STAGE
#undef PG8_LDA
#undef PG8_LDB
#undef PG8_MMA
#undef UNIT_OF
}

DI int gu_perm(int n) { return (n < DFF) ? ((n >> 4) * 32 + (n & 15)) : (((n - DFF) >> 4) * 32 + 16 + ((n - DFF) & 15)); }
DI void tr_strip(const float* src, int ldsrc, int nvalid, bf16_t* dst, int lddst, int kcol0, int k0, int n0, int perm, float* tl, const int tid) {
  constexpr int TS = 257;
#pragma unroll
  for (int jj = 0; jj < 8; ++jj) {
    const int k = (tid >> 6) + 8 * jj, n = (tid & 63) * 4;
    f32x4 v = {0.f, 0.f, 0.f, 0.f};
    if (n0 + n < nvalid) v = *(const f32x4*)(src + (size_t)(k0 + k) * ldsrc + n0 + n);
    tl[k * TS + n] = v[0]; tl[k * TS + n + 1] = v[1]; tl[k * TS + n + 2] = v[2]; tl[k * TS + n + 3] = v[3];
  }
  __syncthreads();
#pragma unroll
  for (int jj = 0; jj < 4; ++jj) {
    const int idx = tid + 512 * jj, n = idx >> 3, kc = (idx & 7) * 8;
    float f[8];
#pragma unroll
    for (int j = 0; j < 8; ++j) f[j] = tl[(kc + j) * TS + n];
    const int nd = perm ? gu_perm(n0 + n) : (n0 + n);
    *(u32x4*)(dst + (size_t)nd * lddst + kcol0 + k0 + kc) = (u32x4){pk2(f[0], f[1]), pk2(f[2], f[3]), pk2(f[4], f[5]), pk2(f[6], f[7])};
  }
  __syncthreads();
}

DI void prep_phase(const Params& P, char* smem, const int wid0) {
  PHASE_IDS;
  float* tl = (float*)smem;
  char* ws = P.ws;
  constexpr int J_IN0 = 128, J_GU = 352, J_DN = 176, J_IN1 = 80, J_OUT1 = 64, J_OUT0B = 64;
  constexpr int J_TR = J_IN0 + 2 * J_GU + 2 * J_DN + J_IN1 + J_OUT1 + J_OUT0B;
  constexpr int J_QA = 384, J_QR = 640, J_OF = 0, J_MOD = 384, J_ROPE = 1;
  constexpr int J_ALL = J_TR + J_QA + J_QR + J_OF + J_MOD + J_ROPE;
  for (int job = bid; job < J_ALL; job += nb) {
    int j = job;
    if (j < J_TR) {
      if (j < J_IN0) { const int kt = j & 15, ns = j >> 4; tr_strip(P.even_w_in, 1952, 1952, (bf16_t*)(ws + W_IN0), 1024, 0, kt * 64, ns * 256, 0, tl, tid); continue; }
      j -= J_IN0;
      if (j < 2 * J_GU) { const int l = j / J_GU; j -= l * J_GU; const int kt = j & 15, ns = j >> 4;
        tr_strip(P.w_gu + (size_t)l * 1024 * 5632, 5632, 5632, (bf16_t*)(ws + (l ? W_GU1 : W_GU0)), 1024, 0, kt * 64, ns * 256, 1, tl, tid); continue; }
      j -= 2 * J_GU;
      if (j < 2 * J_DN) { const int l = j / J_DN; j -= l * J_DN; const int kt = j % 44, ns = j / 44;
        tr_strip(P.w_dn + (size_t)l * DFF * 1024, 1024, 1024, (bf16_t*)(ws + (l ? W_DN1 : W_DN0)), DFF, 0, kt * 64, ns * 256, 0, tl, tid); continue; }
      j -= 2 * J_DN;
      if (j < J_IN1) { const int kt = j & 15, ns = j >> 4; tr_strip(P.odd_w_in, 1280, 1280, (bf16_t*)(ws + W_IN1), 1024, 0, kt * 64, ns * 256, 0, tl, tid); continue; }
      j -= J_IN1;
      if (j < J_OUT1) { const int kt = j & 15, ns = j >> 4; tr_strip(P.odd_w_out, 1024, 1024, (bf16_t*)(ws + W_OUT1), 1024, 0, kt * 64, ns * 256, 0, tl, tid); continue; }
      j -= J_OUT1;
      { const int kt = j & 15, ns = j >> 4; tr_strip(P.even_w_out, 1024, 1024, (bf16_t*)(ws + W_OUT0), 1024, 0, kt * 64, ns * 256, 0, tl, tid); continue; }
    }
    j -= J_TR;
    if (j < J_QA) {
      const int o = j * 512 + tid, k = o & 255, r = o >> 8, h = r / 96, n = r - h * 96;
      int sc = n;
      if (n >= 64) { const int p = n - 64; sc = 64 + ((p < 8) ? p : (p < 16) ? (8 + p) : (p < 24) ? (p - 8) : p); }
      const float v = P.w_q_up[(size_t)k * 768 + h * 96 + sc] * P.q_norm[k];
      ((bf16_t*)(ws + W_Q))[(size_t)r * 256 + k] = (bf16_t)(pk2(v, 0.f) & 0xffff);
      continue;
    }
    j -= J_QA;
    if (j < J_QR) {
      const int o = j * 512 + tid, cidx = o & 255, r = o >> 8;
      float v = 0.f;
      if (r < 768) {
        const int h = r / 96, n = r - h * 96;
        if (n < 64) { if (cidx < 128) v = P.w_uk[((size_t)h * 128 + cidx) * 64 + n]; }
        else v = (cidx == 128 + (n - 64)) ? 1.f : 0.f;
      } else {
        const int rv = r - 768, h = rv >> 6, vv = rv & 63;
        if (cidx < 128) v = P.w_uv[((size_t)h * 128 + cidx) * 64 + vv];
      }
      ((bf16_t*)(ws + W_KV))[(size_t)r * 256 + cidx] = (bf16_t)(pk2(v, 0.f) & 0xffff);
      continue;
    }
    j -= J_QR;
    j -= J_OF;
    if (j < J_MOD) {
      const int l = j / 192, r = j % 192, kc = r / 12, jc = r % 12, col = jc * 512 + tid;
      float* sv = (float*)smem;
      __syncthreads();
      if (tid < 320) { const int bb = tid >> 6, k = kc * 64 + (tid & 63); const float v = (bb < 4) ? P.c[bb * 1024 + k] : P.c_ctx[k]; sv[tid] = v / (1.f + __expf(-v)); }
      __syncthreads();
      const float* w = P.mod_w + ((size_t)l * 1024 + kc * 64) * 6144 + col;
      float a0 = 0.f, a1 = 0.f, a2 = 0.f, a3 = 0.f, a4 = 0.f;
#pragma unroll 8
      for (int k = 0; k < 64; ++k) { const float wv = w[(size_t)k * 6144]; a0 += sv[k] * wv; a1 += sv[64 + k] * wv; a2 += sv[128 + k] * wv; a3 += sv[192 + k] * wv; a4 += sv[256 + k] * wv; }
      if (kc == 0) { const float b = P.mod_b[l * 6144 + col]; a0 += b; a1 += b; a2 += b; a3 += b; a4 += b; }
      float* mv = (float*)(ws + MISC_MODV) + (size_t)l * 5 * 6144 + col;
      unsafeAtomicAdd(mv, a0); unsafeAtomicAdd(mv + 6144, a1); unsafeAtomicAdd(mv + 2 * 6144, a2); unsafeAtomicAdd(mv + 3 * 6144, a3); unsafeAtomicAdd(mv + 4 * 6144, a4);
      __syncthreads();
      continue;
    }
    j -= J_MOD;
    {
      for (int i = tid; i < 128 * 24; i += 512) {
        const int pos = i / 24, f = i % 24;
        float inv; float* dst;
        if (f < 8) { inv = powf(10000.f, -(float)f / 8.f); dst = (float*)(ws + MISC_ROPEM) + (pos * 8 + f) * 2; }
        else { inv = powf(10000.f, -(float)(f - 8) / 16.f); dst = (float*)(ws + MISC_ROPES) + (pos * 16 + (f - 8)) * 2; }
        const float ang = (float)pos * inv;
        dst[0] = cosf(ang); dst[1] = sinf(ang);
      }
    }
  }
}

DI float wave_sum(float v) {
#pragma unroll
  for (int o = 32; o > 0; o >>= 1) v += __shfl_xor(v, o);
  return v;
}
DI void norm_phase(const float* h_lat, const float* h_ctx, const float* modl, int sh_off, int sc_off, bf16_t* a, int nrows, const int wid0,
                   const float* parts = nullptr, int nparts = 0, const float* gate = nullptr, float* hout_ctx = nullptr) {
  PHASE_IDS;
  const int lane = tid & 63, gw = bid * 8 + (tid >> 6), nw = nb * 8;
  for (int row = gw; row < nrows; row += nw) {
    const float* src = (row < T_LAT) ? h_lat + (size_t)row * DM : h_ctx + (size_t)(row - T_LAT) * DM;
    const int bb = (row < T_LAT) ? (row >> 13) : 4;
    f32x4 v[4]; float ss = 0.f;
#pragma unroll
    for (int j = 0; j < 4; ++j) {
      v[j] = *(const f32x4*)(src + lane * 4 + 256 * j);
      if (parts && row >= T_LAT) {
        f32x4 ps = {0.f, 0.f, 0.f, 0.f};
        for (int s = 0; s < nparts; ++s) ps += *(const f32x4*)(parts + ((size_t)s * T_CTX + (row - T_LAT)) * DM + lane * 4 + 256 * j);
        v[j] += *(const f32x4*)(gate + 4 * 6144 + lane * 4 + 256 * j) * ps;
        *(f32x4*)(hout_ctx + (size_t)(row - T_LAT) * DM + lane * 4 + 256 * j) = v[j];
      }
      ss += v[j][0] * v[j][0] + v[j][1] * v[j][1] + v[j][2] * v[j][2] + v[j][3] * v[j][3];
    }
    ss = wave_sum(ss);
    const float r = rsqrtf(ss * (1.f / DM) + EPS);
    const float* sh = modl + bb * 6144 + sh_off; const float* sc = modl + bb * 6144 + sc_off;
#pragma unroll
    for (int j = 0; j < 4; ++j) {
      const int c = lane * 4 + 256 * j;
      const f32x4 s1 = *(const f32x4*)(sc + c), s0 = *(const f32x4*)(sh + c);
      f32x4 y = v[j] * r * (s1 + 1.f) + s0;
      *(u32x2*)(a + (size_t)row * DM + c) = (u32x2){pk2(y[0], y[1]), pk2(y[2], y[3])};
    }
  }
}
DI void final_norm_phase(const float* h, const float* gain, float* out, const int wid0) {
  PHASE_IDS;
  const int lane = tid & 63, gw = bid * 8 + (tid >> 6), nw = nb * 8;
  for (int row = gw; row < T_LAT; row += nw) {
    const float* src = h + (size_t)row * DM;
    f32x4 v[4]; float ss = 0.f;
#pragma unroll
    for (int j = 0; j < 4; ++j) { v[j] = *(const f32x4*)(src + lane * 4 + 256 * j); ss += v[j][0] * v[j][0] + v[j][1] * v[j][1] + v[j][2] * v[j][2] + v[j][3] * v[j][3]; }
    ss = wave_sum(ss);
    const float r = rsqrtf(ss * (1.f / DM) + EPS);
#pragma unroll
    for (int j = 0; j < 4; ++j) {
      const int c = lane * 4 + 256 * j;
      *(f32x4*)(out + (size_t)row * DM + c) = v[j] * r * *(const f32x4*)(gain + c);
    }
  }
}
DI void mla_prep_phase(const Params& P, const int wid0) {
  const bf16_t* p0 = (const bf16_t*)(P.ws + S_OFF);
  bf16_t* qn = (bf16_t*)(P.ws + QN_OFF);
  bf16_t* a2 = (bf16_t*)(P.ws + A2_OFF);
  const float* ropem = (const float*)(P.ws + MISC_ROPEM);
  PHASE_IDS;
  const int lane = tid & 63, gw = bid * 8 + (tid >> 6), nw = nb * 8;
  for (int row = gw; row < T_ALL; row += nw) {
    const bf16_t* src = p0 + (size_t)row * 2048;
    const u32x2 q = *(const u32x2*)(src + 4 * lane);
    const float q0 = bflo(q[0]), q1 = bfhi(q[0]), q2 = bflo(q[1]), q3 = bfhi(q[1]);
    const float rq = rsqrtf(wave_sum(q0 * q0 + q1 * q1 + q2 * q2 + q3 * q3) * (1.f / 256.f) + EPS);
    *(u32x2*)(qn + (size_t)row * 256 + 4 * lane) = (u32x2){pk2(q0 * rq, q1 * rq), pk2(q2 * rq, q3 * rq)};
    const unsigned kk = *(const unsigned*)(src + 256 + 2 * lane);
    const float k0 = bflo(kk), k1 = bfhi(kk);
    const float rk = rsqrtf(wave_sum(k0 * k0 + k1 * k1) * (1.f / 128.f) + EPS);
    const int s = (row < T_LAT) ? (row & (SEQ - 1)) : -1;
    bf16_t* dst = a2 + (size_t)row * 256;
    if (lane < 48) *(unsigned*)(dst + 160 + 2 * lane) = 0u;
    *(unsigned*)(dst + 2 * lane) = pk2(k0 * rk * P.kv_norm[2 * lane], k1 * rk * P.kv_norm[2 * lane + 1]);
    if (lane < 16) {
      const int i = lane, i1 = (i < 8) ? i : (8 + i), f = i & 7;
      float x1 = __uint_as_float((unsigned)src[384 + i1] << 16), x2 = __uint_as_float((unsigned)src[384 + i1 + 8] << 16);
      float o1 = x1, o2 = x2;
      if (s >= 0) {
        const int pos = (i < 8) ? (s >> 6) : (s & 63);
        const float cs = ropem[(pos * 8 + f) * 2], sn = ropem[(pos * 8 + f) * 2 + 1];
        o1 = x1 * cs - x2 * sn; o2 = x1 * sn + x2 * cs;
      }
      dst[128 + i] = (bf16_t)(pk2(o1, 0.f) & 0xffff);
      dst[144 + i] = (bf16_t)(pk2(o2, 0.f) & 0xffff);
    }
  }
}

template <int MODE> struct ACfg;
template <> struct ACfg<0> { static constexpr int DQK = 96, DV = 64, NQT = 1, KS = 208, VS = 192, VOFF = 13312, NCH = 3; };
template <> struct ACfg<1> { static constexpr int DQK = 64, DV = 64, NQT = 1, KS = 144, VS = 192, VOFF = 9216, NCH = 2; };
template <> struct ACfg<2> { static constexpr int DQK = 64, DV = 64, NQT = 1, KS = 144, VS = 192, VOFF = 9216, NCH = 2; };
constexpr int ABUF = 25600;
constexpr int ATT_BIAS_OFF = 4 * ABUF;

DI int crow(int i, int h) { return (i & 3) + 8 * (i >> 2) + 4 * h; }
DI int clampi(int v, int lo, int hi) { return v < lo ? lo : (v > hi ? hi : v); }

template <int MODE>
DI void attn_item(const Params& P, int item, char* smem, const int tid) {
  using C = ACfg<MODE>;
  constexpr int KST = C::DQK / 16, VT = C::DV / 32, NQT = C::NQT, NCH = C::NCH;
  const int w = tid >> 6, lane = tid & 63, c = lane & 31, hh = lane >> 5;
  const int q4 = (lane & 15) >> 2, p4 = lane & 3, g1 = (lane >> 4) & 1;
  char* ws = P.ws;

  const bf16_t* qptr[NQT]; bf16_t* optr[NQT];
  int ntiles = 0;
  float sc2;
  const bf16_t* gbase; unsigned loff[NCH]; int ldst[NCH]; bool lval[NCH];
  size_t tile_stride = 0;
  int tok_ctx0 = 0, tok_lat0 = 0;
  int ldp = 0;
  int na_r = 0, na_rs = 0, na_rlo = 0, na_qc = 0; bool plain = false;
  int swa_j = 0, swa_tlo = 0;
  float m_init = 0.f, l_init = 0.f;

  if (MODE == 0) {
    sc2 = 0.10206207261596575f * LOG2E;
    int b, head, token;
    if (item < 1024) { b = item >> 8; head = item & 7; token = b * SEQ + ((item & 255) >> 3) * 256 + w * 32 + c; ntiles = 4 + SEQ / 64; }
    else { const int ci = item - 1024; b = ci >> 3; head = ci & 7; token = T_LAT + b * NCTX + 32 * w + c; ntiles = 4; }
    qptr[0] = (const bf16_t*)(ws + QMLA_OFF) + ((size_t)token * 8 + head) * 96;
    optr[0] = (bf16_t*)(ws + ATTO_OFF) + (size_t)token * 1024 + head * 64;
    gbase = (const bf16_t*)(ws + KVF_OFF) + (size_t)(b * 8 + head) * NKEY * 160;
    tile_stride = 64 * 160;
#pragma unroll
    for (int jj = 0; jj < NCH; ++jj) {
      const int n = tid + 512 * jj, row = n / 20, ck = n - row * 20;
      lval[jj] = n < 1280; loff[jj] = (n < 1280 ? n : n - 512) * 8;
      ldst[jj] = (ck < 12) ? (row * C::KS + ck * 16) : (C::VOFF + row * C::VS + (ck - 12) * 16);
    }
  } else if (MODE == 1) {
    sc2 = 0.125f * LOG2E;
    const bf16_t* p0 = (const bf16_t*)(ws + S_OFF);
    int b, head, token;
    if (item < 1024) {
      b = item >> 8; head = (item >> 5) & 7; const int r0 = (item & 31) * 4;
      na_r = r0 + (w >> 1); na_qc = 32 * (w & 1) + c; token = b * SEQ + na_r * 64 + na_qc;
      na_rlo = clampi(r0 - 4, 0, 120); const int rhi = clampi(r0 - 1, 0, 120) + 7;
      na_rs = clampi(na_r - 4, 0, 120); ntiles = 4 + rhi - na_rlo + 1;
      tok_lat0 = b * SEQ + na_rlo * 64;
    } else { const int ci = item - 1024; b = ci >> 3; head = ci & 7; token = T_LAT + b * NCTX + 32 * w + c; ntiles = 4; plain = true; }
    tok_ctx0 = T_LAT + b * NCTX; ldp = 2048;
    qptr[0] = p0 + (size_t)token * 2048 + 416 + head * 64;
    optr[0] = (bf16_t*)(ws + ATTO_OFF) + (size_t)token * 1024 + 512 + head * 64;
    const int row = tid >> 3, ck = tid & 7;
    gbase = p0 + 416 + 512 + head * 64;
    loff[0] = row * 2048 + ck * 8; ldst[0] = row * C::KS + ck * 16; lval[0] = true;
    loff[1] = loff[0] + 512; ldst[1] = C::VOFF + row * C::VS + ck * 16; lval[1] = true;
    if (tid < 465) ((float*)(smem + ATT_BIAS_OFF))[tid] = P.rel_bias[head * 465 + tid] * LOG2E;
  } else {
    sc2 = 0.125f * LOG2E;
    const bf16_t* p1 = (const bf16_t*)(ws + S_OFF);
    const int b = item >> 9, kvh = item & 1; swa_j = (item & 511) >> 1;
    const int hq = kvh * 8 + w;
    {
      const int token = b * SEQ + 32 * swa_j + c;
      qptr[0] = p1 + (size_t)token * 1280 + hq * 64;
      optr[0] = (bf16_t*)(ws + O1_OFF) + (size_t)token * 1024 + hq * 64;
    }
    swa_tlo = max(0, (32 * swa_j - 128) >> 6); const int thi = min(127, (32 * swa_j + 159) >> 6);
    ntiles = 4 + thi - swa_tlo + 1;
    tok_ctx0 = T_LAT + b * NCTX; tok_lat0 = b * SEQ + swa_tlo * 64; ldp = 1280;
    const int row = tid >> 3, ck = tid & 7;
    gbase = p1 + 1024 + kvh * 64;
    loff[0] = row * 1280 + ck * 8; ldst[0] = row * C::KS + ck * 16; lval[0] = true;
    loff[1] = loff[0] + 128; ldst[1] = C::VOFF + row * C::VS + ck * 16; lval[1] = true;
    m_init = P.sinks[hq] * LOG2E; l_init = hh ? 0.f : 1.f;
  }

  auto tile_off = [&](int t) -> size_t {
    if (MODE == 0) return (size_t)t * tile_stride;
    const int tok = (t < 4) ? (tok_ctx0 + 64 * t) : (tok_lat0 + 64 * (t - 4));
    return (size_t)tok * ldp;
  };

  bf16x8 qf[NQT][KST];
#pragma unroll
  for (int qt = 0; qt < NQT; ++qt)
#pragma unroll
    for (int ks = 0; ks < KST; ++ks) qf[qt][ks] = *(const bf16x8*)(qptr[qt] + 16 * ks + 8 * hh);

  f32x16 o[NQT][VT];
  f32x16 nm[NQT];
  float mrun[NQT], lrun[NQT];
#pragma unroll
  for (int qt = 0; qt < NQT; ++qt) {
    mrun[qt] = m_init; lrun[qt] = l_init;
#pragma unroll
    for (int i = 0; i < 16; ++i) nm[qt][i] = -m_init;
#pragma unroll
    for (int vt = 0; vt < VT; ++vt)
#pragma unroll
      for (int i = 0; i < 16; ++i) o[qt][vt][i] = 0.f;
  }

  u32x4 stg0[NCH], stg1[NCH], stg2[NCH];
  {
    const size_t off = tile_off(0);
#pragma unroll
    for (int jj = 0; jj < NCH; ++jj) stg2[jj] = *(const u32x4*)(gbase + off + loff[jj]);
    {
      const size_t off1 = tile_off(min(1, ntiles - 1));
#pragma unroll
      for (int jj = 0; jj < NCH; ++jj) stg0[jj] = *(const u32x4*)(gbase + off1 + loff[jj]);
    }
    {
      const size_t off2 = tile_off(min(2, ntiles - 1));
#pragma unroll
      for (int jj = 0; jj < NCH; ++jj) stg1[jj] = *(const u32x4*)(gbase + off2 + loff[jj]);
    }
#pragma unroll
    for (int jj = 0; jj < NCH; ++jj) if (lval[jj]) *(u32x4*)(smem + ldst[jj]) = stg2[jj];
  }
  __syncthreads();

  const bool grpB = (w >= 4);
  const int sh = grpB ? 0 : 1;
  bf16x8 pf[NQT][2][2];
  f32x16 s[NQT][2];
  bool pf_ok = false, s_ok = false;
#define SB_ __builtin_amdgcn_sched_barrier(0)
  constexpr int CH = KST / 2;

  auto tile_active = [&](int ti) -> bool {
    bool a = (ti >= 0) && (ti < ntiles);
    if (MODE == 1 && !plain && ti >= 4) { const int R = na_rlo + (ti - 4); a = a && (R >= na_rs) && (R < na_rs + 8); }
    return a;
  };
  auto do_pv = [&](const char* vbuf) {
    s16x4 va[2][VT][2];
    const char* vb0 = vbuf + C::VOFF + (4 * hh + q4) * C::VS + (16 * g1 + 4 * p4) * 2;
#pragma unroll
    for (int vt = 0; vt < VT; ++vt) {
      va[0][vt][0] = __builtin_amdgcn_ds_read_tr16_b64_v4i16((LAS s16x4*)(vb0 + 64 * vt));
      va[0][vt][1] = __builtin_amdgcn_ds_read_tr16_b64_v4i16((LAS s16x4*)(vb0 + 64 * vt + 8 * C::VS));
    }
#pragma unroll
    for (int g = 0; g < 4; ++g) {
      if (g + 1 < 4) {
#pragma unroll
        for (int vt = 0; vt < VT; ++vt) {
          va[(g + 1) & 1][vt][0] = __builtin_amdgcn_ds_read_tr16_b64_v4i16((LAS s16x4*)(vb0 + 16 * (g + 1) * C::VS + 64 * vt));
          va[(g + 1) & 1][vt][1] = __builtin_amdgcn_ds_read_tr16_b64_v4i16((LAS s16x4*)(vb0 + (16 * (g + 1) + 8) * C::VS + 64 * vt));
        }
      }
      SB_;
#pragma unroll
      for (int vt = 0; vt < VT; ++vt) {
        const bf16x8 vfrag = __builtin_shufflevector(va[g & 1][vt][0], va[g & 1][vt][1], 0, 1, 2, 3, 4, 5, 6, 7);
#pragma unroll
        for (int qt = 0; qt < NQT; ++qt) o[qt][vt] = __builtin_amdgcn_mfma_f32_32x32x16_bf16(vfrag, pf[qt][g >> 1][g & 1], o[qt][vt], 0, 0, 0);
      }
      SB_;
    }
  };
  auto do_s = [&](const char* kbuf) {
    bf16x8 ka[2][CH];
    const char* kb0 = kbuf + c * C::KS + (8 * hh) * 2;
#pragma unroll
    for (int k = 0; k < CH; ++k) ka[0][k] = *(const bf16x8*)(kb0 + 32 * k);
#pragma unroll
    for (int j = 0; j < 4; ++j) {
      if (j + 1 < 4) {
#pragma unroll
        for (int k = 0; k < CH; ++k) ka[(j + 1) & 1][k] = *(const bf16x8*)(kb0 + 32 * ((j + 1) >> 1) * C::KS + 32 * (((j + 1) & 1) * CH + k));
      }
      SB_;
#pragma unroll
      for (int k = 0; k < CH; ++k)
#pragma unroll
        for (int qt = 0; qt < NQT; ++qt)
          s[qt][j >> 1] = __builtin_amdgcn_mfma_f32_32x32x16_bf16(ka[j & 1][k], qf[qt][(j & 1) * CH + k], (k == 0 && (j & 1) == 0) ? nm[qt] : s[qt][j >> 1], 0, 0, 0);
      SB_;
    }
  };
  auto do_sm = [&](int ti) {
    const int na_dr = na_rlo + (ti - 4) - na_r + 7;
#pragma unroll
    for (int qt = 0; qt < NQT; ++qt) {
      if (MODE == 1 && !plain && ti >= 4) {
        const int qs = clampi(na_qc - 8, 0, 48);
        const float* bb = (const float*)(smem + ATT_BIAS_OFF) + (na_dr * 31 + 15 - na_qc);
#pragma unroll
        for (int mt = 0; mt < 2; ++mt)
#pragma unroll
          for (int i = 0; i < 16; ++i) {
            const int kidx = 32 * mt + crow(i, hh);
            const bool ok = (unsigned)(kidx - qs) < 16u;
            s[qt][mt][i] = ok ? s[qt][mt][i] + bb[kidx] : -1e30f;
          }
      }
      if (MODE == 2 && ti >= 4) {
        const int dbase = 64 * (swa_tlo + ti - 4) - (32 * swa_j + c) + 128;
#pragma unroll
        for (int mt = 0; mt < 2; ++mt)
#pragma unroll
          for (int i = 0; i < 16; ++i) {
            const int kidx = 32 * mt + crow(i, hh);
            const bool ok = (unsigned)(dbase + kidx) <= 256u;
            s[qt][mt][i] = ok ? s[qt][mt][i] : -1e30f;
          }
      }
      float ls = 0.f;
#pragma unroll
      for (int mt = 0; mt < 2; ++mt) {
        float p[16];
#pragma unroll
        for (int i = 0; i < 16; ++i) { p[i] = __builtin_amdgcn_exp2f(s[qt][mt][i]); ls += p[i]; }
#pragma unroll
        for (int sp = 0; sp < 2; ++sp) {
          u32x4 pk = {pk2(p[8 * sp], p[8 * sp + 1]), pk2(p[8 * sp + 2], p[8 * sp + 3]), pk2(p[8 * sp + 4], p[8 * sp + 5]), pk2(p[8 * sp + 6], p[8 * sp + 7])};
          pf[qt][mt][sp] = __builtin_bit_cast(bf16x8, pk);
        }
      }
      const bool force = (MODE != 2) && (ti == 0);
      if (force || __any(!(ls < 1.0e18f))) {
        float mx = -1e30f;
#pragma unroll
        for (int mt = 0; mt < 2; ++mt)
#pragma unroll
          for (int i = 0; i < 16; ++i) mx = fmaxf(mx, s[qt][mt][i]);
        mx = fmaxf(mx, __shfl_xor(mx, 32));
        const float mraw = mx + mrun[qt];
        const float mnew = force ? mraw : fmaxf(mrun[qt], mraw);
        const float delta = mnew - mrun[qt];
        const float alpha = force ? 0.f : __builtin_amdgcn_exp2f(-delta);
        mrun[qt] = mnew;
        lrun[qt] *= alpha;
#pragma unroll
        for (int vt = 0; vt < VT; ++vt)
#pragma unroll
          for (int i = 0; i < 16; ++i) o[qt][vt][i] *= alpha;
#pragma unroll
        for (int i = 0; i < 16; ++i) nm[qt][i] = -mnew;
        ls = 0.f;
#pragma unroll
        for (int mt = 0; mt < 2; ++mt) {
          float p[16];
#pragma unroll
          for (int i = 0; i < 16; ++i) { p[i] = __builtin_amdgcn_exp2f(s[qt][mt][i] - delta); ls += p[i]; }
#pragma unroll
          for (int sp = 0; sp < 2; ++sp) {
            u32x4 pk = {pk2(p[8 * sp], p[8 * sp + 1]), pk2(p[8 * sp + 2], p[8 * sp + 3]), pk2(p[8 * sp + 4], p[8 * sp + 5]), pk2(p[8 * sp + 6], p[8 * sp + 7])};
            pf[qt][mt][sp] = __builtin_bit_cast(bf16x8, pk);
          }
        }
      }
      lrun[qt] += ls;
    }
  };

  auto step = [&](int t, u32x4 (&sl)[NCH], u32x4 (&ss)[NCH]) {
    const int tt = t + sh;
    const char* cur = smem + (tt & 3) * ABUF;
    const char* prv = smem + ((tt - 1) & 3) * ABUF;
    char* nxt = smem + ((t + 2) & 3) * ABUF;
    {
      const size_t off = tile_off(min(t + 4, ntiles - 1));
#pragma unroll
      for (int jj = 0; jj < NCH; ++jj) sl[jj] = *(const u32x4*)(gbase + off + loff[jj]);
    }
    const bool active = tile_active(tt);
    if (!grpB) {
      if (pf_ok) do_pv(prv);
      pf_ok = active;
      if (active) { do_s(cur); do_sm(tt); }
    } else {
      if (s_ok) { do_sm(tt - 1); do_pv(prv); }
      s_ok = active;
      if (active) do_s(cur);
    }
    if (t + 2 < ntiles) {
#pragma unroll
      for (int jj = 0; jj < NCH; ++jj) if (lval[jj]) *(u32x4*)(nxt + ldst[jj]) = ss[jj];
    }
    __syncthreads();
  };
  for (int t = -1; t <= ntiles; t += 3) { step(t, stg2, stg0); step(t + 1, stg0, stg1); step(t + 2, stg1, stg2); }
#pragma unroll
  for (int qt = 0; qt < NQT; ++qt) {
    const float lt = lrun[qt] + __shfl_xor(lrun[qt], 32);
    const float inv = 1.f / lt;
#pragma unroll
    for (int vt = 0; vt < VT; ++vt)
#pragma unroll
      for (int g = 0; g < 4; ++g) {
        const f32x16& ov = o[qt][vt];
        *(u32x2*)(optr[qt] + 32 * vt + 8 * g + 4 * hh) =
            (u32x2){pk2(ov[4 * g] * inv, ov[4 * g + 1] * inv), pk2(ov[4 * g + 2] * inv, ov[4 * g + 3] * inv)};
      }
  }
}

constexpr int NPHASE = 18;
#ifndef REP_ATT
#define REP_ATT 1
#endif
#ifndef REP_GEMM
#define REP_GEMM 1
#endif
constexpr int LDS_BYTES = GEMM_LDS;
#define XB_TMO      128
#define XB_XCNT(j)  (256  + 64 * (j))
#define XB_XSUB(j)  (1280 + 64 * (j))
#define XB_XGEN(j)  (2304 + 64 * (j))
#define XB_TOP      3328
#define XB_TOPGEN   3392
#define XB_SPIN_CAP (1u << 21)
DI unsigned xb_ld(unsigned* p) { return __hip_atomic_load(p, __ATOMIC_RELAXED, __HIP_MEMORY_SCOPE_AGENT); }
DI unsigned xb_add(unsigned* p, unsigned v) { return __hip_atomic_fetch_add(p, v, __ATOMIC_RELAXED, __HIP_MEMORY_SCOPE_AGENT); }
DI unsigned xb_xcc_id() { return (unsigned)__builtin_amdgcn_s_getreg((3 << 11) | 20) & 0xFu; }
#define XB_SPIN(cond, bar) do { unsigned _sp = 0; while (cond) { __builtin_amdgcn_s_sleep(1); \
    if ((++_sp & 255u) == 0u) { if (xb_ld(&(bar)[XB_TMO])) break; if (_sp > XB_SPIN_CAP) { atomicAdd(&(bar)[XB_TMO], 1u); break; } } } } while (0)
DI void xcd_barrier_complete(unsigned* bar, unsigned x, unsigned G, unsigned& nloc, unsigned& nx) {
  unsigned sum, cnt, mine, sp = 0u;
  for (;;) {
    sum = 0u; cnt = 0u; mine = 0u;
#pragma unroll
    for (unsigned j = 0; j < 16; ++j) { const unsigned c = xb_ld(&bar[XB_XCNT(j)]); sum += c; cnt += (c > 0u) ? 1u : 0u; mine = (j == x) ? c : mine; }
    if (sum == G) break;
    __builtin_amdgcn_s_sleep(1);
    if ((++sp & 255u) == 0u) { if (xb_ld(&bar[XB_TMO])) break; if (sp > XB_SPIN_CAP) { atomicAdd(&bar[XB_TMO], 1u); break; } }
  }
  nloc = mine > 0u ? mine : 1u; nx = cnt > 0u ? cnt : 1u;
}
DI void grid_barrier(unsigned* bar, volatile LAS unsigned* st, const unsigned x, const int wid0) {
  PHASE_IDS;
  asm volatile("s_waitcnt vmcnt(0)" ::: "memory");
  __syncthreads();
  if (tid == 0) {
    __builtin_amdgcn_s_waitcnt(0);
    unsigned nloc = st[0], nx = st[1];
    if (nloc == 0u) { xcd_barrier_complete(bar, x, (unsigned)nb, nloc, nx); st[0] = nloc; st[1] = nx; }
    const unsigned old = xb_add(&bar[XB_XSUB(x)], 1u);
    const unsigned gen = old / nloc;
    if (old + 1u == (gen + 1u) * nloc) {
      __builtin_amdgcn_fence(__ATOMIC_RELEASE, "agent");
      asm volatile("s_waitcnt vmcnt(0)" ::: "memory");
      const unsigned og = xb_add(&bar[XB_TOP], 1u);
      const unsigned tg = og / nx;
      if (og + 1u == (tg + 1u) * nx) xb_add(&bar[XB_TOPGEN], 1u);
      else XB_SPIN(xb_ld(&bar[XB_TOPGEN]) == tg, bar);
      __builtin_amdgcn_fence(__ATOMIC_ACQUIRE, "agent");
      xb_add(&bar[XB_XGEN(x)], 1u);
      asm volatile("s_waitcnt vmcnt(0)" ::: "memory");
    } else {
      XB_SPIN(xb_ld(&bar[XB_XGEN(x)]) == gen, bar);
      __builtin_amdgcn_fence(__ATOMIC_ACQUIRE, "agent");
      asm volatile("s_waitcnt vmcnt(0)" ::: "memory");
    }
  }
  __syncthreads();
}

__global__ void __launch_bounds__(512) fwd_megakernel(Params P_unused, int ph_lo, int ph_hi) {
  extern __shared__ __attribute__((aligned(16))) char smem[];
  cg::grid_group grid = cg::this_grid();
  typedef const __attribute__((address_space(4))) Params* KP;
  LAS unsigned char* ldsp = (LAS unsigned char*)smem;
  const int wid0 = __builtin_amdgcn_readfirstlane((int)threadIdx.x >> 6);
  __shared__ uint4 xb_words;
  volatile LAS unsigned* xb_st = (volatile LAS unsigned*)&xb_words;
  const unsigned xb_x = xb_xcc_id();
  if (threadIdx.x == 0) {
    xb_words = make_uint4(0u, 0u, 0u, 0u);
    KP kp0 = (KP)__builtin_amdgcn_kernarg_segment_ptr();
    (void)xb_add(&((unsigned*)(kp0->ws + MISC_BAR))[XB_XCNT(xb_x)], 1u);
  }
  __syncthreads();
  if (ph_hi > 1000) grid.sync();
#define PH_BEGIN KP kp_ = (KP)__builtin_amdgcn_kernarg_segment_ptr(); asm volatile("" : "+s"(kp_)); const Params& P = *(const Params*)kp_; \
  char* ws = P.ws; const float* modv = (const float*)(ws + MISC_MODV); float* h = (float*)(ws + H_OFF); \
  bf16_t* abuf = (bf16_t*)(ws + A_OFF); bf16_t* sbuf = (bf16_t*)(ws + S_OFF); (void)modv; (void)h; (void)abuf; (void)sbuf;
  if (ph_lo <= 0 && 0 < ph_hi) {
    PH_BEGIN
    prep_phase(P, smem, wid0);
    if (0 + 1 < ph_hi) grid_barrier((unsigned*)(ws + MISC_BAR), xb_st, xb_x, wid0);
  }
  if (ph_lo <= 1 && 1 < ph_hi) {
    PH_BEGIN
    norm_phase(P.x, P.ctx, modv, 0, 1024, abuf, T_ALL, wid0);
    if (1 + 1 < ph_hi) grid_barrier((unsigned*)(ws + MISC_BAR), xb_st, xb_x, wid0);
  }
  if (ph_lo <= 2 && 2 < ph_hi) {
    PH_BEGIN
    for (int rep_ = 0; rep_ < REP_GEMM; ++rep_) { __syncthreads(); EpiArgs e{}; e.out = sbuf; e.ldo = 2048; e.qscale = 0.125f * LOG2E; e.qs_lo = 416; e.qs_hi = 928; gemm_phase<EPI_BF16>(abuf, (const bf16_t*)(ws + W_IN0), T_ALL, 2048, 1024, e, ldsp, wid0); }
    if (2 + 1 < ph_hi) grid_barrier((unsigned*)(ws + MISC_BAR), xb_st, xb_x, wid0);
  }
  if (ph_lo <= 3 && 3 < ph_hi) {
    PH_BEGIN
    mla_prep_phase(P, wid0);
    if (3 + 1 < ph_hi) grid_barrier((unsigned*)(ws + MISC_BAR), xb_st, xb_x, wid0);
  }
  if (ph_lo <= 4 && 4 < ph_hi) {
    PH_BEGIN
    { EpiArgs e{}; e.out = ws + QMLA_OFF; e.ldo = 768; e.rope = (const float*)(ws + MISC_ROPEM); e.qscale = 0.10206207261596575f * LOG2E; e.qs_lo = 0; e.qs_hi = 768;
      gemm_phase<EPI_ROPE_MLA>((const bf16_t*)(ws + QN_OFF), (const bf16_t*)(ws + W_Q), T_ALL, 768, 256, e, ldsp, wid0);
      EpiArgs e2{}; e2.out = ws + KVF_OFF; e2.ldo = 1280; __syncthreads();
      gemm_phase<EPI_KVF>((const bf16_t*)(ws + A2_OFF), (const bf16_t*)(ws + W_KV), T_ALL, 1280, 256, e2, ldsp, wid0); }
    if (4 + 1 < ph_hi) grid_barrier((unsigned*)(ws + MISC_BAR), xb_st, xb_x, wid0);
  }
  if (ph_lo <= 5 && 5 < ph_hi) {
    PH_BEGIN
    PHASE_IDS;
    for (int rep_ = 0; rep_ < REP_ATT; ++rep_)
    {
      if (wid0 >= 4) __builtin_amdgcn_s_setprio(1);
      for (int it = bid; it < 1056; it += nb) attn_item<0>(P, it, smem, tid);
      asm volatile("" ::: "memory");
      for (int it = bid; it < 1056; it += nb) attn_item<1>(P, it, smem, opq_v(tid));
      __builtin_amdgcn_s_setprio(0);
    }
    if (5 + 1 < ph_hi) grid_barrier((unsigned*)(ws + MISC_BAR), xb_st, xb_x, wid0);
  }
  if (ph_lo <= 6 && 6 < ph_hi) {
    PH_BEGIN
    for (int rep_ = 0; rep_ < REP_GEMM; ++rep_) { __syncthreads(); EpiArgs e{}; e.out = h; e.hin_lat = P.x; e.hin_ctx = P.ctx; e.gate = modv + 2048;
                gemm_phase<EPI_RESID>((const bf16_t*)(ws + ATTO_OFF), (const bf16_t*)(ws + W_OUT0), T_LAT, 1024, 1024, e, ldsp, wid0);
                EpiArgs e2{}; e2.out = ws + PART_OFF; __syncthreads();
                gemm_phase<EPI_F32P>((const bf16_t*)(ws + ATTO_OFF) + (size_t)T_LAT * 1024, (const bf16_t*)(ws + W_OUT0), T_CTX, 1024, 1024, e2, ldsp, wid0, 4); }
    if (6 + 1 < ph_hi) grid_barrier((unsigned*)(ws + MISC_BAR), xb_st, xb_x, wid0);
  }
  if (ph_lo <= 7 && 7 < ph_hi) {
    PH_BEGIN
    norm_phase(h, P.ctx, modv, 3072, 4096, abuf, T_ALL, wid0, (const float*)(ws + PART_OFF), 4, modv + 2048, h + (size_t)T_LAT * DM);
    if (7 + 1 < ph_hi) grid_barrier((unsigned*)(ws + MISC_BAR), xb_st, xb_x, wid0);
  }
  if (ph_lo <= 8 && 8 < ph_hi) {
    PH_BEGIN
    for (int rep_ = 0; rep_ < REP_GEMM; ++rep_) { __syncthreads(); EpiArgs e{}; e.out = sbuf; e.ldo = DFF; gemm_phase<EPI_SWIGLU>(abuf, (const bf16_t*)(ws + W_GU0), T_ALL, 2 * DFF, 1024, e, ldsp, wid0); }
    if (8 + 1 < ph_hi) grid_barrier((unsigned*)(ws + MISC_BAR), xb_st, xb_x, wid0);
  }
  if (ph_lo <= 9 && 9 < ph_hi) {
    PH_BEGIN
    { EpiArgs e{}; e.out = h; e.hin_lat = h; e.hin_ctx = h + (size_t)T_LAT * DM; e.gate = modv + 5120;
                gemm_phase<EPI_RESID>(sbuf, (const bf16_t*)(ws + W_DN0), T_LAT, 1024, DFF, e, ldsp, wid0);
                EpiArgs e2{}; e2.out = ws + PART_OFF; __syncthreads();
                gemm_phase<EPI_F32P>(sbuf + (size_t)T_LAT * DFF, (const bf16_t*)(ws + W_DN0), T_CTX, 1024, DFF, e2, ldsp, wid0, 11); }
    if (9 + 1 < ph_hi) grid_barrier((unsigned*)(ws + MISC_BAR), xb_st, xb_x, wid0);
  }
  if (ph_lo <= 10 && 10 < ph_hi) {
    PH_BEGIN
    norm_phase(h, h + (size_t)T_LAT * DM, modv + 5 * 6144, 0, 1024, abuf, T_ALL, wid0, (const float*)(ws + PART_OFF), 11, modv + 5120, h + (size_t)T_LAT * DM);
    if (10 + 1 < ph_hi) grid_barrier((unsigned*)(ws + MISC_BAR), xb_st, xb_x, wid0);
  }
  if (ph_lo <= 11 && 11 < ph_hi) {
    PH_BEGIN
    for (int rep_ = 0; rep_ < REP_GEMM; ++rep_) { __syncthreads(); EpiArgs e{}; e.out = sbuf; e.ldo = 1280; e.rope = (const float*)(ws + MISC_ROPES); e.qscale = 0.125f * LOG2E; e.qs_lo = 0; e.qs_hi = 1024;
                 gemm_phase<EPI_ROPE_SWA>(abuf, (const bf16_t*)(ws + W_IN1), T_ALL, 1280, 1024, e, ldsp, wid0); }
    if (11 + 1 < ph_hi) grid_barrier((unsigned*)(ws + MISC_BAR), xb_st, xb_x, wid0);
  }
  if (ph_lo <= 12 && 12 < ph_hi) {
    PH_BEGIN
    PHASE_IDS;
    if (wid0 >= 4) __builtin_amdgcn_s_setprio(1);
    for (int it = bid; it < 2048; it += nb) attn_item<2>(P, it, smem, tid);
    __builtin_amdgcn_s_setprio(0);
    if (12 + 1 < ph_hi) grid_barrier((unsigned*)(ws + MISC_BAR), xb_st, xb_x, wid0);
  }
  if (ph_lo <= 13 && 13 < ph_hi) {
    PH_BEGIN
    { EpiArgs e{}; e.out = h; e.hin_lat = h; e.hin_ctx = h + (size_t)T_LAT * DM; e.gate = modv + 5 * 6144 + 2048;
                 gemm_phase<EPI_RESID>((const bf16_t*)(ws + O1_OFF), (const bf16_t*)(ws + W_OUT1), T_LAT, 1024, 1024, e, ldsp, wid0); }
    if (13 + 1 < ph_hi) grid_barrier((unsigned*)(ws + MISC_BAR), xb_st, xb_x, wid0);
  }
  if (ph_lo <= 14 && 14 < ph_hi) {
    PH_BEGIN
    norm_phase(h, h + (size_t)T_LAT * DM, modv + 5 * 6144, 3072, 4096, abuf, T_LAT, wid0);
    if (14 + 1 < ph_hi) grid_barrier((unsigned*)(ws + MISC_BAR), xb_st, xb_x, wid0);
  }
  if (ph_lo <= 15 && 15 < ph_hi) {
    PH_BEGIN
    for (int rep_ = 0; rep_ < REP_GEMM; ++rep_) { __syncthreads(); EpiArgs e{}; e.out = sbuf; e.ldo = DFF; gemm_phase<EPI_SWIGLU>(abuf, (const bf16_t*)(ws + W_GU1), T_LAT, 2 * DFF, 1024, e, ldsp, wid0); }
    if (15 + 1 < ph_hi) grid_barrier((unsigned*)(ws + MISC_BAR), xb_st, xb_x, wid0);
  }
  if (ph_lo <= 16 && 16 < ph_hi) {
    PH_BEGIN
    { EpiArgs e{}; e.out = h; e.hin_lat = h; e.hin_ctx = h + (size_t)T_LAT * DM; e.gate = modv + 5 * 6144 + 5120;
                 gemm_phase<EPI_RESID>(sbuf, (const bf16_t*)(ws + W_DN1), T_LAT, 1024, DFF, e, ldsp, wid0); }
    if (16 + 1 < ph_hi) grid_barrier((unsigned*)(ws + MISC_BAR), xb_st, xb_x, wid0);
  }
  if (ph_lo <= 17 && 17 < ph_hi) {
    PH_BEGIN
    final_norm_phase(h, P.final_norm, P.out, wid0);
    if (17 + 1 < ph_hi) grid_barrier((unsigned*)(ws + MISC_BAR), xb_st, xb_x, wid0);
  }
}

extern "C" void kernel_launch(void* const* d_in, const int* in_sizes, int n_in, void* d_out, int out_size, void* d_ws, size_t ws_size,
                              hipStream_t stream) {
  static int grid_blocks = 0;
  if (grid_blocks == 0) {
    if (n_in != 20 || ws_size < WS_END) { fprintf(stderr, "kernel_launch: unexpected n_in %d / ws_size %zu (need %zu)\n", n_in, ws_size, (size_t)WS_END); grid_blocks = -1; return; }
    int dev = 0, cus = 0, per_cu = 0;
    hipGetDevice(&dev);
    hipDeviceGetAttribute(&cus, hipDeviceAttributeMultiprocessorCount, dev);
    hipFuncSetAttribute((const void*)fwd_megakernel, hipFuncAttributeMaxDynamicSharedMemorySize, LDS_BYTES);
    hipOccupancyMaxActiveBlocksPerMultiprocessor(&per_cu, (const void*)fwd_megakernel, 512, LDS_BYTES);
    if (per_cu < 1) { fprintf(stderr, "kernel_launch: occupancy query says %d blocks per CU\n", per_cu); per_cu = 1; }
    grid_blocks = cus;
    (void)hipGetLastError();
  }
  if (grid_blocks < 0) return;
  Params p{};
  const float** pp = (const float**)&p;
  for (int i = 0; i < 20; ++i) pp[i] = (const float*)d_in[i];
  p.out = (float*)d_out; p.ws = (char*)d_ws;
  hipMemsetAsync((char*)d_ws + MISC, 0, MiB, stream);
  int lo = 0, hi = NPHASE;
  void* args[] = {&p, &lo, &hi};
  hipError_t e = hipLaunchCooperativeKernel((const void*)fwd_megakernel, dim3(grid_blocks), dim3(512), args, LDS_BYTES, stream);
  if (e != hipSuccess) fprintf(stderr, "cooperative launch failed: %s (grid %d)\n", hipGetErrorString(e), grid_blocks);
}
```

```cpp
#include <hip/hip_runtime.h>
#include <hip/hip_cooperative_groups.h>
#include <cstdio>
namespace cg = cooperative_groups;

#define DI __device__ __forceinline__
typedef unsigned short bf16_t;
typedef short bf16x8 __attribute__((ext_vector_type(8)));
typedef short s16x4 __attribute__((ext_vector_type(4)));
typedef float f32x2 __attribute__((ext_vector_type(2)));
typedef float f32x4 __attribute__((ext_vector_type(4)));
typedef float f32x16 __attribute__((ext_vector_type(16)));
typedef __bf16 bf16x2_t __attribute__((ext_vector_type(2)));
typedef unsigned u32x2 __attribute__((ext_vector_type(2)));
typedef unsigned u32x4 __attribute__((ext_vector_type(4)));
#define LAS __attribute__((address_space(3)))

DI int opq_v(int x) { asm volatile("" : "+v"(x)); return x; }
DI int opq_s(int x) { asm volatile("" : "+s"(x)); return x; }
#define PHASE_IDS const int tid = opq_v((opq_s(wid0) << 6) | (int)__builtin_amdgcn_mbcnt_hi((unsigned)opq_s(-1), __builtin_amdgcn_mbcnt_lo((unsigned)opq_s(-1), 0u))); const int bid = opq_s((int)blockIdx.x); const int nb = opq_s((int)gridDim.x); (void)tid; (void)bid; (void)nb
DI unsigned pk2(float a, float b) { f32x2 v = {a, b}; return __builtin_bit_cast(unsigned, __builtin_convertvector(v, bf16x2_t)); }
DI float bflo(unsigned u) { return __uint_as_float(u << 16); }
DI float bfhi(unsigned u) { return __uint_as_float(u & 0xffff0000u); }

constexpr int T_LAT = 32768, T_CTX = 1024, T_ALL = 33792, DM = 1024, SEQ = 8192, NCTX = 256, NKEY = 8448;
constexpr int DFF = 2816;
constexpr float EPS = 1e-6f, LOG2E = 1.4426950408889634f;

constexpr size_t MiB = 1u << 20;
constexpr size_t W_IN0 = 0, W_Q = 4 * MiB, W_KV = 4 * MiB + 384 * 1024, W_OUT0 = 5 * MiB, W_GU0 = 8 * MiB, W_GU1 = 19 * MiB, W_DN0 = 30 * MiB, W_DN1 = 36 * MiB,
                 W_IN1 = 42 * MiB, W_OUT1 = 45 * MiB;
constexpr size_t MISC = 47 * MiB;
constexpr size_t MISC_MODV = MISC;
constexpr size_t MISC_ROPEM = MISC + 256 * 1024;
constexpr size_t MISC_ROPES = MISC + 272 * 1024;
constexpr size_t MISC_BAR = MISC + 512 * 1024;
constexpr size_t H_OFF = 48 * MiB;
constexpr size_t QMLA_OFF = H_OFF;
constexpr size_t KVF_OFF = H_OFF + 50 * MiB;
constexpr size_t ATTO_OFF = 184 * MiB;
constexpr size_t QN_OFF = 412 * MiB;
constexpr size_t A2_OFF = 429 * MiB;
constexpr size_t A_OFF = 180 * MiB;
constexpr size_t S_OFF = 279 * MiB;
constexpr size_t O1_OFF = S_OFF + 83 * MiB;
constexpr size_t PART_OFF = 461 * MiB;
constexpr size_t WS_END = 505 * MiB;

struct Params {
  const float *x, *c, *ctx, *c_ctx, *mod_w, *mod_b, *even_w_in, *q_norm, *kv_norm, *w_q_up, *w_uk, *w_uv, *rel_bias, *even_w_out,
      *odd_w_in, *sinks, *odd_w_out, *w_gu, *w_dn, *final_norm;
  float* out;
  char* ws;
};

constexpr int BM = 256, BK = 64, HALF = 128, HT = HALF * BK, NXCD = 8, WGM = 8;
constexpr int GEMM_LDS = 8 * HT * 2;

DI int lds_byte(int r, int c) {
  int st = (r >> 4) * 2 + (c >> 5), rr = r & 15, cc = c & 31, ob = rr * 64 + cc * 2;
  return st * 1024 + (ob ^ (((ob >> 9) & 1) << 5));
}
DI void stage_rc(int b, int& R, int& C) {
  int st = b / 1024, sb = b % 1024, swz = sb ^ (((sb >> 9) & 1) << 5);
  R = (st >> 1) * 16 + swz / 64; C = (st & 1) * 32 + (swz % 64) / 2;
}

enum { EPI_BF16 = 0, EPI_ROPE_MLA = 1, EPI_ROPE_SWA = 2, EPI_RESID = 3, EPI_SWIGLU = 4, EPI_F32P = 5, EPI_KVF = 6 };
struct EpiArgs {
  void* out; int ldo;
  const float* hin_lat; const float* hin_ctx;
  const float* gate;
  const float* rope;
  float qscale; int qs_lo, qs_hi;
};

template <int EPI>
DI void gemm_phase(const bf16_t* __restrict__ A, const bf16_t* __restrict__ Bt, int M, int N, int K, const EpiArgs e, LAS unsigned char* lds, const int wid0, const int ksplit = 1) {
  PHASE_IDS;
  const int wid = __builtin_amdgcn_readfirstlane(tid >> 6), lane = tid & 63, wr = wid >> 2, wc = wid & 3, fr = lane & 15, fq = lane >> 4;
  const int kloop = K / ksplit;
  const int nt = kloop / BK;
  const int nM = M / BM, nN = N / BM, ntile = nM * nN, nwg = ntile * ksplit;
  unsigned voff[2];
#pragma unroll
  for (int i = 0; i < 2; ++i) { int R, C; stage_rc(tid * 16 + i * 8192, R, C); voff[i] = (unsigned)(R * K + C) * 2u; }
  const size_t kstep = (size_t)(BK * 2);
  const size_t hstep = (size_t)HALF * K * 2;
  const size_t tstep = 2 * hstep;
  const unsigned ldsw = (unsigned)wid * 1024u;
  const int aoff = lds_byte(wr * 64 + fr, fq * 8), boff = lds_byte(wc * 32 + fr, fq * 8);
  constexpr int HTB = HALF * BK * 2;
#define PG8_SA(b, h) (((b) * 2 + (h)) * HTB)
#define PG8_SB(b, h) ((4 + (b) * 2 + (h)) * HTB)
#define PG8_STAGE(bufoff, gbase) do { _Pragma("unroll") for (int _i = 0; _i < 2; ++_i) \
    __builtin_amdgcn_global_load_lds((const unsigned*)((const char*)(gbase) + voff[_i]), (LAS unsigned*)(lds + (bufoff) + ldsw + _i * 8192), 16, 0, 0); } while (0)
#define PG8_LDA(dst, b, h) do { _Pragma("unroll") for (int m = 0; m < 4; ++m) _Pragma("unroll") for (int k = 0; k < 2; ++k) dst[m][k] = *(const LAS bf16x8*)(lds + PG8_SA(b, h) + aoff + m * 2048 + k * 1024); } while (0)
#define PG8_LDB(dst, b, h) do { _Pragma("unroll") for (int n = 0; n < 2; ++n) _Pragma("unroll") for (int k = 0; k < 2; ++k) dst[n][k] = *(const LAS bf16x8*)(lds + PG8_SB(b, h) + boff + n * 2048 + k * 1024); } while (0)
#define PG8_MMA(ai, bj, At_, Bt_) do { __builtin_amdgcn_s_setprio(1); _Pragma("unroll") for (int m = 0; m < 4; ++m) _Pragma("unroll") for (int n = 0; n < 2; ++n) _Pragma("unroll") for (int k = 0; k < 2; ++k) \
    acc[ai][bj][m][n] = __builtin_amdgcn_mfma_f32_16x16x32_bf16(Bt_[n][k], At_[m][k], acc[ai][bj][m][n], 0, 0, 0); __builtin_amdgcn_s_setprio(0); } while (0)
#define PG8_WAIT_V(n) asm volatile("s_waitcnt vmcnt(" #n ")" ::: "memory")
#define PG8_WAIT_L(n) asm volatile("s_waitcnt lgkmcnt(" #n ")" ::: "memory")
#define PG8_BAR __builtin_amdgcn_s_barrier()
#define PG8_SCHED __builtin_amdgcn_sched_barrier(0)
#define UNIT_OF(L_, pm_, pn_, ks_) do { ks_ = (L_) / ntile; int wgid = (L_) - ks_ * ntile; { const int q = ntile / NXCD, r = ntile % NXCD, xcd = wgid % NXCD, off = wgid / NXCD; \
      wgid = (xcd < r ? xcd * (q + 1) : r * (q + 1) + (xcd - r) * q) + off; } \
    const int nig = WGM * nN, gid = wgid / nig, fm = gid * WGM, gsz = (nM - fm) < WGM ? (nM - fm) : WGM; \
    pm_ = fm + ((wgid % nig) % gsz); pn_ = (wgid % nig) / gsz; } while (0)

  int L = bid;
  if (L >= nwg) return;
  int pm, pn, ksu, npm = 0, npn = 0, nksu = 0;
  UNIT_OF(L, pm, pn, ksu);
  f32x4 acc[2][2][4][2];
#pragma unroll
  for (int a = 0; a < 2; ++a)
#pragma unroll
    for (int b = 0; b < 2; ++b)
#pragma unroll
      for (int m = 0; m < 4; ++m)
#pragma unroll
        for (int n = 0; n < 2; ++n) acc[a][b][m][n] = (f32x4){0.f, 0.f, 0.f, 0.f};
  bf16x8 At[4][2], B0[2][2], B1[2][2];
  const char* cA = (const char*)A + (size_t)pm * tstep + (size_t)ksu * kloop * 2; const char* cB = (const char*)Bt + (size_t)pn * tstep + (size_t)ksu * kloop * 2;
  PG8_STAGE(PG8_SB(0, 0), cB); PG8_STAGE(PG8_SA(0, 0), cA); PG8_STAGE(PG8_SB(0, 1), cB + hstep); PG8_STAGE(PG8_SA(0, 1), cA + hstep);
  if (wr == 1) PG8_BAR;
  PG8_WAIT_V(4); PG8_BAR;
  PG8_STAGE(PG8_SB(1, 0), cB + kstep); PG8_STAGE(PG8_SA(1, 0), cA + kstep); PG8_STAGE(PG8_SB(1, 1), cB + hstep + kstep);
  PG8_WAIT_V(6); PG8_BAR;
  for (;;) {
    const int Ln = L + nb;
    const bool has_next = Ln < nwg;
    if (has_next) UNIT_OF(Ln, npm, npn, nksu);
    const char* nA = has_next ? (const char*)A + (size_t)npm * tstep + (size_t)nksu * kloop * 2 : cA; const char* nB = has_next ? (const char*)Bt + (size_t)npn * tstep + (size_t)nksu * kloop * 2 : cB;
    for (int t = 0; t < nt; t += 2) {
      const bool last = (t == nt - 2);
      const char* a1 = cA + (size_t)(t + 1) * kstep;
      const char* a2 = last ? nA : cA + (size_t)(t + 2) * kstep; const char* b2 = last ? nB : cB + (size_t)(t + 2) * kstep;
      const char* a3 = a2 + kstep; const char* b3 = b2 + kstep;
      PG8_LDB(B0, 0, 0); PG8_SCHED; PG8_LDA(At, 0, 0); PG8_STAGE(PG8_SA(1, 1), a1 + hstep);
      PG8_WAIT_L(8); PG8_BAR; PG8_WAIT_L(0); PG8_MMA(0, 0, At, B0); PG8_BAR; PG8_SCHED;
      PG8_LDB(B1, 0, 1); PG8_STAGE(PG8_SB(0, 0), b2);
      PG8_BAR; PG8_WAIT_L(0); PG8_MMA(0, 1, At, B1); PG8_BAR;
      PG8_LDA(At, 0, 1); PG8_STAGE(PG8_SA(0, 0), a2);
      PG8_BAR; PG8_WAIT_L(0); PG8_MMA(1, 0, At, B0); PG8_BAR; PG8_SCHED;
      PG8_STAGE(PG8_SB(0, 1), b2 + hstep);
      PG8_WAIT_V(6); PG8_BAR; PG8_MMA(1, 1, At, B1); PG8_BAR;
      PG8_LDB(B0, 1, 0); PG8_SCHED; PG8_LDA(At, 1, 0); PG8_STAGE(PG8_SA(0, 1), a2 + hstep);
      PG8_WAIT_L(8); PG8_BAR; PG8_WAIT_L(0); PG8_MMA(0, 0, At, B0); PG8_BAR; PG8_SCHED;
      PG8_LDB(B1, 1, 1); PG8_STAGE(PG8_SB(1, 0), b3);
      PG8_BAR; PG8_WAIT_L(0); PG8_MMA(0, 1, At, B1); PG8_BAR;
      PG8_LDA(At, 1, 1); PG8_STAGE(PG8_SA(1, 0), a3);
      PG8_BAR; PG8_WAIT_L(0); PG8_MMA(1, 0, At, B0); PG8_BAR; PG8_SCHED;
      PG8_STAGE(PG8_SB(1, 1), b3 + hstep);
      PG8_WAIT_V(6); PG8_BAR; PG8_MMA(1, 1, At, B1); PG8_BAR;
    }
    const int brow = pm * BM, bcol = pn * BM;
#pragma unroll
    for (int ai = 0; ai < 2; ++ai)
#pragma unroll
      for (int m = 0; m < 4; ++m) {
        const int row = brow + ai * HALF + wr * 64 + m * 16 + fr;
#pragma unroll
        for (int bj = 0; bj < 2; ++bj) {
          const int gcol0 = bcol + bj * HALF + wc * 32;
          f32x4 v0 = acc[ai][bj][m][0], v1 = acc[ai][bj][m][1];
          if (EPI == EPI_KVF) {
            const int b = (row < T_LAT) ? (row >> 13) : ((row - T_LAT) >> 8);
            const int key = (row < T_LAT) ? (NCTX + (row & (SEQ - 1))) : ((row - T_LAT) & 255);
            int hd, within;
            if (gcol0 < 768) { hd = gcol0 / 96; within = gcol0 - hd * 96; } else { hd = (gcol0 - 768) >> 6; within = 96 + ((gcol0 - 768) & 63); }
            bf16_t* o = (bf16_t*)e.out + ((size_t)(b * 8 + hd) * NKEY + key) * 160 + within + 4 * fq;
            *(u32x2*)o = (u32x2){pk2(v0[0], v0[1]), pk2(v0[2], v0[3])};
            *(u32x2*)(o + 16) = (u32x2){pk2(v1[0], v1[1]), pk2(v1[2], v1[3])};
          } else
          if (EPI == EPI_F32P) {
            float* o = (float*)e.out + ((size_t)ksu * M + row) * N + gcol0 + 4 * fq;
            *(f32x4*)o = v0; *(f32x4*)(o + 16) = v1;
          } else
          if (EPI == EPI_BF16 || EPI == EPI_ROPE_MLA || EPI == EPI_ROPE_SWA) {
            if (EPI != EPI_BF16) {
              bool isrope; int usecol, f0, nf;
              if (EPI == EPI_ROPE_MLA) { isrope = ((gcol0 >> 5) % 3) == 2; usecol = fq >> 1; f0 = (4 * fq) & 7; nf = 8; }
              else { isrope = gcol0 < 1152; usecol = (gcol0 >> 5) & 1; f0 = 4 * fq; nf = 16; }
              if (isrope && row < T_LAT) {
                const int s = row & (SEQ - 1), pos = usecol ? (s & 63) : (s >> 6);
                const f32x4* tp = (const f32x4*)(e.rope + (size_t)(pos * nf + f0) * 2);
                const f32x4 c01 = tp[0], c23 = tp[1];
                f32x4 a0 = v0, a1 = v1;
                v0[0] = a0[0] * c01[0] - a1[0] * c01[1]; v1[0] = a0[0] * c01[1] + a1[0] * c01[0];
                v0[1] = a0[1] * c01[2] - a1[1] * c01[3]; v1[1] = a0[1] * c01[3] + a1[1] * c01[2];
                v0[2] = a0[2] * c23[0] - a1[2] * c23[1]; v1[2] = a0[2] * c23[1] + a1[2] * c23[0];
                v0[3] = a0[3] * c23[2] - a1[3] * c23[3]; v1[3] = a0[3] * c23[3] + a1[3] * c23[2];
              }
            }
            if (gcol0 >= e.qs_lo && gcol0 < e.qs_hi) { v0 *= e.qscale; v1 *= e.qscale; }
            bf16_t* o = (bf16_t*)e.out + (size_t)row * e.ldo + gcol0 + 4 * fq;
            *(u32x2*)o = (u32x2){pk2(v0[0], v0[1]), pk2(v0[2], v0[3])};
            *(u32x2*)(o + 16) = (u32x2){pk2(v1[0], v1[1]), pk2(v1[2], v1[3])};
          } else if (EPI == EPI_RESID) {
            const float* hin = (row < T_LAT) ? e.hin_lat + (size_t)row * DM : e.hin_ctx + (size_t)(row - T_LAT) * DM;
            const int bb = (row < T_LAT) ? (row >> 13) : 4;
            const float* g = e.gate + bb * 6144;
            const int c0 = gcol0 + 4 * fq;
            float* o = (float*)e.out + (size_t)row * DM;
            f32x4 h0 = *(const f32x4*)(hin + c0), h1 = *(const f32x4*)(hin + c0 + 16);
            f32x4 g0 = *(const f32x4*)(g + c0), g1 = *(const f32x4*)(g + c0 + 16);
            *(f32x4*)(o + c0) = h0 + g0 * v0;
            *(f32x4*)(o + c0 + 16) = h1 + g1 * v1;
          } else {
            f32x4 r;
#pragma unroll
            for (int i = 0; i < 4; ++i) { const float gq = v0[i]; r[i] = gq * __builtin_amdgcn_rcpf(1.f + __builtin_amdgcn_exp2f(-LOG2E * gq)) * v1[i]; }
            bf16_t* o = (bf16_t*)e.out + (size_t)row * e.ldo + (gcol0 >> 1) + 4 * fq;
            *(u32x2*)o = (u32x2){pk2(r[0], r[1]), pk2(r[2], r[3])};
          }
        }
      }
    if (!has_next) break;
#pragma unroll
    for (int a = 0; a < 2; ++a)
#pragma unroll
      for (int b = 0; b < 2; ++b)
#pragma unroll
        for (int m = 0; m < 4; ++m)
#pragma unroll
          for (int n = 0; n < 2; ++n) acc[a][b][m][n] = (f32x4){0.f, 0.f, 0.f, 0.f};
    L = Ln; pm = npm; pn = npn; ksu = nksu; cA = nA; cB = nB;
  }
  PG8_WAIT_V(0);
  if (wr == 0) PG8_BAR;
  PG8_BAR;
#undef PG8_SA
#undef PG8_SB
#undef PG8_STAGE
#undef PG8_LDA
#undef PG8_LDB
#undef PG8_MMA
#undef UNIT_OF
}

DI int gu_perm(int n) { return (n < DFF) ? ((n >> 4) * 32 + (n & 15)) : (((n - DFF) >> 4) * 32 + 16 + ((n - DFF) & 15)); }
DI void tr_strip(const float* src, int ldsrc, int nvalid, bf16_t* dst, int lddst, int kcol0, int k0, int n0, int perm, float* tl, const int tid) {
  constexpr int TS = 257;
#pragma unroll
  for (int jj = 0; jj < 8; ++jj) {
    const int k = (tid >> 6) + 8 * jj, n = (tid & 63) * 4;
    f32x4 v = {0.f, 0.f, 0.f, 0.f};
    if (n0 + n < nvalid) v = *(const f32x4*)(src + (size_t)(k0 + k) * ldsrc + n0 + n);
    tl[k * TS + n] = v[0]; tl[k * TS + n + 1] = v[1]; tl[k * TS + n + 2] = v[2]; tl[k * TS + n + 3] = v[3];
  }
  __syncthreads();
#pragma unroll
  for (int jj = 0; jj < 4; ++jj) {
    const int idx = tid + 512 * jj, n = idx >> 3, kc = (idx & 7) * 8;
    float f[8];
#pragma unroll
    for (int j = 0; j < 8; ++j) f[j] = tl[(kc + j) * TS + n];
    const int nd = perm ? gu_perm(n0 + n) : (n0 + n);
    *(u32x4*)(dst + (size_t)nd * lddst + kcol0 + k0 + kc) = (u32x4){pk2(f[0], f[1]), pk2(f[2], f[3]), pk2(f[4], f[5]), pk2(f[6], f[7])};
  }
  __syncthreads();
}

DI void prep_phase(const Params& P, char* smem, const int wid0) {
  PHASE_IDS;
  float* tl = (float*)smem;
  char* ws = P.ws;
  constexpr int J_IN0 = 128, J_GU = 352, J_DN = 176, J_IN1 = 80, J_OUT1 = 64, J_OUT0B = 64;
  constexpr int J_TR = J_IN0 + 2 * J_GU + 2 * J_DN + J_IN1 + J_OUT1 + J_OUT0B;
  constexpr int J_QA = 384, J_QR = 640, J_OF = 0, J_MOD = 384, J_ROPE = 1;
  constexpr int J_ALL = J_TR + J_QA + J_QR + J_OF + J_MOD + J_ROPE;
  for (int job = bid; job < J_ALL; job += nb) {
    int j = job;
    if (j < J_TR) {
      if (j < J_IN0) { const int kt = j & 15, ns = j >> 4; tr_strip(P.even_w_in, 1952, 1952, (bf16_t*)(ws + W_IN0), 1024, 0, kt * 64, ns * 256, 0, tl, tid); continue; }
      j -= J_IN0;
      if (j < 2 * J_GU) { const int l = j / J_GU; j -= l * J_GU; const int kt = j & 15, ns = j >> 4;
        tr_strip(P.w_gu + (size_t)l * 1024 * 5632, 5632, 5632, (bf16_t*)(ws + (l ? W_GU1 : W_GU0)), 1024, 0, kt * 64, ns * 256, 1, tl, tid); continue; }
      j -= 2 * J_GU;
      if (j < 2 * J_DN) { const int l = j / J_DN; j -= l * J_DN; const int kt = j % 44, ns = j / 44;
        tr_strip(P.w_dn + (size_t)l * DFF * 1024, 1024, 1024, (bf16_t*)(ws + (l ? W_DN1 : W_DN0)), DFF, 0, kt * 64, ns * 256, 0, tl, tid); continue; }
      j -= 2 * J_DN;
      if (j < J_IN1) { const int kt = j & 15, ns = j >> 4; tr_strip(P.odd_w_in, 1280, 1280, (bf16_t*)(ws + W_IN1), 1024, 0, kt * 64, ns * 256, 0, tl, tid); continue; }
      j -= J_IN1;
      if (j < J_OUT1) { const int kt = j & 15, ns = j >> 4; tr_strip(P.odd_w_out, 1024, 1024, (bf16_t*)(ws + W_OUT1), 1024, 0, kt * 64, ns * 256, 0, tl, tid); continue; }
      j -= J_OUT1;
      { const int kt = j & 15, ns = j >> 4; tr_strip(P.even_w_out, 1024, 1024, (bf16_t*)(ws + W_OUT0), 1024, 0, kt * 64, ns * 256, 0, tl, tid); continue; }
    }
    j -= J_TR;
    if (j < J_QA) {
      const int o = j * 512 + tid, k = o & 255, r = o >> 8, h = r / 96, n = r - h * 96;
      int sc = n;
      if (n >= 64) { const int p = n - 64; sc = 64 + ((p < 8) ? p : (p < 16) ? (8 + p) : (p < 24) ? (p - 8) : p); }
      const float v = P.w_q_up[(size_t)k * 768 + h * 96 + sc] * P.q_norm[k];
      ((bf16_t*)(ws + W_Q))[(size_t)r * 256 + k] = (bf16_t)(pk2(v, 0.f) & 0xffff);
      continue;
    }
    j -= J_QA;
    if (j < J_QR) {
      const int o = j * 512 + tid, cidx = o & 255, r = o >> 8;
      float v = 0.f;
      if (r < 768) {
        const int h = r / 96, n = r - h * 96;
        if (n < 64) { if (cidx < 128) v = P.w_uk[((size_t)h * 128 + cidx) * 64 + n]; }
        else v = (cidx == 128 + (n - 64)) ? 1.f : 0.f;
      } else {
        const int rv = r - 768, h = rv >> 6, vv = rv & 63;
        if (cidx < 128) v = P.w_uv[((size_t)h * 128 + cidx) * 64 + vv];
      }
      ((bf16_t*)(ws + W_KV))[(size_t)r * 256 + cidx] = (bf16_t)(pk2(v, 0.f) & 0xffff);
      continue;
    }
    j -= J_QR;
    j -= J_OF;
    if (j < J_MOD) {
      const int l = j / 192, r = j % 192, kc = r / 12, jc = r % 12, col = jc * 512 + tid;
      float* sv = (float*)smem;
      __syncthreads();
      if (tid < 320) { const int bb = tid >> 6, k = kc * 64 + (tid & 63); const float v = (bb < 4) ? P.c[bb * 1024 + k] : P.c_ctx[k]; sv[tid] = v / (1.f + __expf(-v)); }
      __syncthreads();
      const float* w = P.mod_w + ((size_t)l * 1024 + kc * 64) * 6144 + col;
      float a0 = 0.f, a1 = 0.f, a2 = 0.f, a3 = 0.f, a4 = 0.f;
#pragma unroll 8
      for (int k = 0; k < 64; ++k) { const float wv = w[(size_t)k * 6144]; a0 += sv[k] * wv; a1 += sv[64 + k] * wv; a2 += sv[128 + k] * wv; a3 += sv[192 + k] * wv; a4 += sv[256 + k] * wv; }
      if (kc == 0) { const float b = P.mod_b[l * 6144 + col]; a0 += b; a1 += b; a2 += b; a3 += b; a4 += b; }
      float* mv = (float*)(ws + MISC_MODV) + (size_t)l * 5 * 6144 + col;
      unsafeAtomicAdd(mv, a0); unsafeAtomicAdd(mv + 6144, a1); unsafeAtomicAdd(mv + 2 * 6144, a2); unsafeAtomicAdd(mv + 3 * 6144, a3); unsafeAtomicAdd(mv + 4 * 6144, a4);
      __syncthreads();
      continue;
    }
    j -= J_MOD;
    {
      for (int i = tid; i < 128 * 24; i += 512) {
        const int pos = i / 24, f = i % 24;
        float inv; float* dst;
        if (f < 8) { inv = powf(10000.f, -(float)f / 8.f); dst = (float*)(ws + MISC_ROPEM) + (pos * 8 + f) * 2; }
        else { inv = powf(10000.f, -(float)(f - 8) / 16.f); dst = (float*)(ws + MISC_ROPES) + (pos * 16 + (f - 8)) * 2; }
        const float ang = (float)pos * inv;
        dst[0] = cosf(ang); dst[1] = sinf(ang);
      }
    }
  }
}

DI float wave_sum(float v) {
#pragma unroll
  for (int o = 32; o > 0; o >>= 1) v += __shfl_xor(v, o);
  return v;
}
DI void norm_phase(const float* h_lat, const float* h_ctx, const float* modl, int sh_off, int sc_off, bf16_t* a, int nrows, const int wid0,
                   const float* parts = nullptr, int nparts = 0, const float* gate = nullptr, float* hout_ctx = nullptr) {
  PHASE_IDS;
  const int lane = tid & 63, gw = bid * 8 + (tid >> 6), nw = nb * 8;
  for (int row = gw; row < nrows; row += nw) {
    const float* src = (row < T_LAT) ? h_lat + (size_t)row * DM : h_ctx + (size_t)(row - T_LAT) * DM;
    const int bb = (row < T_LAT) ? (row >> 13) : 4;
    f32x4 v[4]; float ss = 0.f;
#pragma unroll
    for (int j = 0; j < 4; ++j) {
      v[j] = *(const f32x4*)(src + lane * 4 + 256 * j);
      if (parts && row >= T_LAT) {
        f32x4 ps = {0.f, 0.f, 0.f, 0.f};
        for (int s = 0; s < nparts; ++s) ps += *(const f32x4*)(parts + ((size_t)s * T_CTX + (row - T_LAT)) * DM + lane * 4 + 256 * j);
        v[j] += *(const f32x4*)(gate + 4 * 6144 + lane * 4 + 256 * j) * ps;
        *(f32x4*)(hout_ctx + (size_t)(row - T_LAT) * DM + lane * 4 + 256 * j) = v[j];
      }
      ss += v[j][0] * v[j][0] + v[j][1] * v[j][1] + v[j][2] * v[j][2] + v[j][3] * v[j][3];
    }
    ss = wave_sum(ss);
    const float r = rsqrtf(ss * (1.f / DM) + EPS);
    const float* sh = modl + bb * 6144 + sh_off; const float* sc = modl + bb * 6144 + sc_off;
#pragma unroll
    for (int j = 0; j < 4; ++j) {
      const int c = lane * 4 + 256 * j;
      const f32x4 s1 = *(const f32x4*)(sc + c), s0 = *(const f32x4*)(sh + c);
      f32x4 y = v[j] * r * (s1 + 1.f) + s0;
      *(u32x2*)(a + (size_t)row * DM + c) = (u32x2){pk2(y[0], y[1]), pk2(y[2], y[3])};
    }
  }
}
DI void final_norm_phase(const float* h, const bf16_t* d, const float* gate, const float* gain, float* out, const int wid0) {
  PHASE_IDS;
  const int lane = tid & 63, gw = bid * 8 + (tid >> 6), nw = nb * 8;
  for (int row = gw; row < T_LAT; row += nw) {
    const float* src = h + (size_t)row * DM;
    const bf16_t* dsrc = d + (size_t)row * DM;
    const float* g = gate + (row >> 13) * 6144;
    f32x4 v[4]; float ss = 0.f;
#pragma unroll
    for (int j = 0; j < 4; ++j) {
      const int c = lane * 4 + 256 * j;
      const u32x2 dd = *(const u32x2*)(dsrc + c);
      const f32x4 dv = {bflo(dd[0]), bfhi(dd[0]), bflo(dd[1]), bfhi(dd[1])};
      v[j] = *(const f32x4*)(src + c) + *(const f32x4*)(g + c) * dv;
      ss += v[j][0] * v[j][0] + v[j][1] * v[j][1] + v[j][2] * v[j][2] + v[j][3] * v[j][3];
    }
    ss = wave_sum(ss);
    const float r = rsqrtf(ss * (1.f / DM) + EPS);
#pragma unroll
    for (int j = 0; j < 4; ++j) {
      const int c = lane * 4 + 256 * j;
      *(f32x4*)(out + (size_t)row * DM + c) = v[j] * r * *(const f32x4*)(gain + c);
    }
  }
}
DI void mla_prep_phase(const Params& P, const int wid0) {
  const bf16_t* p0 = (const bf16_t*)(P.ws + S_OFF);
  bf16_t* qn = (bf16_t*)(P.ws + QN_OFF);
  bf16_t* a2 = (bf16_t*)(P.ws + A2_OFF);
  const float* ropem = (const float*)(P.ws + MISC_ROPEM);
  PHASE_IDS;
  const int lane = tid & 63, gw = bid * 8 + (tid >> 6), nw = nb * 8;
  for (int row = gw; row < T_ALL; row += nw) {
    const bf16_t* src = p0 + (size_t)row * 2048;
    const u32x2 q = *(const u32x2*)(src + 4 * lane);
    const float q0 = bflo(q[0]), q1 = bfhi(q[0]), q2 = bflo(q[1]), q3 = bfhi(q[1]);
    const float rq = rsqrtf(wave_sum(q0 * q0 + q1 * q1 + q2 * q2 + q3 * q3) * (1.f / 256.f) + EPS);
    *(u32x2*)(qn + (size_t)row * 256 + 4 * lane) = (u32x2){pk2(q0 * rq, q1 * rq), pk2(q2 * rq, q3 * rq)};
    const unsigned kk = *(const unsigned*)(src + 256 + 2 * lane);
    const float k0 = bflo(kk), k1 = bfhi(kk);
    const float rk = rsqrtf(wave_sum(k0 * k0 + k1 * k1) * (1.f / 128.f) + EPS);
    const int s = (row < T_LAT) ? (row & (SEQ - 1)) : -1;
    bf16_t* dst = a2 + (size_t)row * 256;
    if (lane < 48) *(unsigned*)(dst + 160 + 2 * lane) = 0u;
    *(unsigned*)(dst + 2 * lane) = pk2(k0 * rk * P.kv_norm[2 * lane], k1 * rk * P.kv_norm[2 * lane + 1]);
    if (lane < 16) {
      const int i = lane, i1 = (i < 8) ? i : (8 + i), f = i & 7;
      float x1 = __uint_as_float((unsigned)src[384 + i1] << 16), x2 = __uint_as_float((unsigned)src[384 + i1 + 8] << 16);
      float o1 = x1, o2 = x2;
      if (s >= 0) {
        const int pos = (i < 8) ? (s >> 6) : (s & 63);
        const float cs = ropem[(pos * 8 + f) * 2], sn = ropem[(pos * 8 + f) * 2 + 1];
        o1 = x1 * cs - x2 * sn; o2 = x1 * sn + x2 * cs;
      }
      dst[128 + i] = (bf16_t)(pk2(o1, 0.f) & 0xffff);
      dst[144 + i] = (bf16_t)(pk2(o2, 0.f) & 0xffff);
    }
  }
}

template <int MODE> struct ACfg;
template <> struct ACfg<0> { static constexpr int DQK = 96, DV = 64, NQT = 1, KS = 208, VS = 192, VOFF = 13312, NCH = 3; };
template <> struct ACfg<1> { static constexpr int DQK = 64, DV = 64, NQT = 1, KS = 144, VS = 192, VOFF = 9216, NCH = 2; };
template <> struct ACfg<2> { static constexpr int DQK = 64, DV = 64, NQT = 1, KS = 144, VS = 192, VOFF = 9216, NCH = 2; };
constexpr int ABUF = 25600;
constexpr int ATT_BIAS_OFF = 4 * ABUF;

DI int crow(int i, int h) { return (i & 3) + 8 * (i >> 2) + 4 * h; }
DI int clampi(int v, int lo, int hi) { return v < lo ? lo : (v > hi ? hi : v); }

template <int MODE>
DI void attn_item(const Params& P, int item, char* smem, const int tid) {
  using C = ACfg<MODE>;
  constexpr int KST = C::DQK / 16, VT = C::DV / 32, NQT = C::NQT, NCH = C::NCH;
  const int w = tid >> 6, lane = tid & 63, c = lane & 31, hh = lane >> 5;
  const int q4 = (lane & 15) >> 2, p4 = lane & 3, g1 = (lane >> 4) & 1;
  char* ws = P.ws;

  const bf16_t* qptr[NQT]; bf16_t* optr[NQT];
  int ntiles = 0;
  float sc2;
  const bf16_t* gbase; unsigned loff[NCH]; int ldst[NCH]; bool lval[NCH];
  size_t tile_stride = 0;
  int tok_ctx0 = 0, tok_lat0 = 0;
  int ldp = 0;
  int na_r = 0, na_rs = 0, na_rlo = 0, na_qc = 0; bool plain = false;
  int swa_j = 0, swa_tlo = 0;
  float m_init = 0.f, l_init = 0.f;

  if (MODE == 0) {
    sc2 = 0.10206207261596575f * LOG2E;
    int b, head, token;
    if (item < 1024) { b = item >> 8; head = item & 7; token = b * SEQ + ((item & 255) >> 3) * 256 + w * 32 + c; ntiles = 4 + SEQ / 64; }
    else { const int ci = item - 1024; b = ci >> 3; head = ci & 7; token = T_LAT + b * NCTX + 32 * w + c; ntiles = 4; }
    qptr[0] = (const bf16_t*)(ws + QMLA_OFF) + ((size_t)token * 8 + head) * 96;
    optr[0] = (bf16_t*)(ws + ATTO_OFF) + (size_t)token * 1024 + head * 64;
    gbase = (const bf16_t*)(ws + KVF_OFF) + (size_t)(b * 8 + head) * NKEY * 160;
    tile_stride = 64 * 160;
#pragma unroll
    for (int jj = 0; jj < NCH; ++jj) {
      const int n = tid + 512 * jj, row = n / 20, ck = n - row * 20;
      lval[jj] = n < 1280; loff[jj] = (n < 1280 ? n : n - 512) * 8;
      ldst[jj] = (ck < 12) ? (row * C::KS + ck * 16) : (C::VOFF + row * C::VS + (ck - 12) * 16);
    }
  } else if (MODE == 1) {
    sc2 = 0.125f * LOG2E;
    const bf16_t* p0 = (const bf16_t*)(ws + S_OFF);
    int b, head, token;
    if (item < 1024) {
      b = item >> 8; head = (item >> 5) & 7; const int r0 = (item & 31) * 4;
      na_r = r0 + (w >> 1); na_qc = 32 * (w & 1) + c; token = b * SEQ + na_r * 64 + na_qc;
      na_rlo = clampi(r0 - 4, 0, 120); const int rhi = clampi(r0 - 1, 0, 120) + 7;
      na_rs = clampi(na_r - 4, 0, 120); ntiles = 4 + rhi - na_rlo + 1;
      tok_lat0 = b * SEQ + na_rlo * 64;
    } else { const int ci = item - 1024; b = ci >> 3; head = ci & 7; token = T_LAT + b * NCTX + 32 * w + c; ntiles = 4; plain = true; }
    tok_ctx0 = T_LAT + b * NCTX; ldp = 2048;
    qptr[0] = p0 + (size_t)token * 2048 + 416 + head * 64;
    optr[0] = (bf16_t*)(ws + ATTO_OFF) + (size_t)token * 1024 + 512 + head * 64;
    const int row = tid >> 3, ck = tid & 7;
    gbase = p0 + 416 + 512 + head * 64;
    loff[0] = row * 2048 + ck * 8; ldst[0] = row * C::KS + ck * 16; lval[0] = true;
    loff[1] = loff[0] + 512; ldst[1] = C::VOFF + row * C::VS + ck * 16; lval[1] = true;
    if (tid < 465) ((float*)(smem + ATT_BIAS_OFF))[tid] = P.rel_bias[head * 465 + tid] * LOG2E;
  } else {
    sc2 = 0.125f * LOG2E;
    const bf16_t* p1 = (const bf16_t*)(ws + S_OFF);
    const int b = item >> 9, kvh = item & 1; swa_j = (item & 511) >> 1;
    const int hq = kvh * 8 + w;
    {
      const int token = b * SEQ + 32 * swa_j + c;
      qptr[0] = p1 + (size_t)token * 1280 + hq * 64;
      optr[0] = (bf16_t*)(ws + O1_OFF) + (size_t)token * 1024 + hq * 64;
    }
    swa_tlo = max(0, (32 * swa_j - 128) >> 6); const int thi = min(127, (32 * swa_j + 159) >> 6);
    ntiles = 4 + thi - swa_tlo + 1;
    tok_ctx0 = T_LAT + b * NCTX; tok_lat0 = b * SEQ + swa_tlo * 64; ldp = 1280;
    const int row = tid >> 3, ck = tid & 7;
    gbase = p1 + 1024 + kvh * 64;
    loff[0] = row * 1280 + ck * 8; ldst[0] = row * C::KS + ck * 16; lval[0] = true;
    loff[1] = loff[0] + 128; ldst[1] = C::VOFF + row * C::VS + ck * 16; lval[1] = true;
    m_init = P.sinks[hq] * LOG2E; l_init = hh ? 0.f : 1.f;
  }

  auto tile_off = [&](int t) -> size_t {
    if (MODE == 0) return (size_t)t * tile_stride;
    const int tok = (t < 4) ? (tok_ctx0 + 64 * t) : (tok_lat0 + 64 * (t - 4));
    return (size_t)tok * ldp;
  };

  bf16x8 qf[NQT][KST];
#pragma unroll
  for (int qt = 0; qt < NQT; ++qt)
#pragma unroll
    for (int ks = 0; ks < KST; ++ks) qf[qt][ks] = *(const bf16x8*)(qptr[qt] + 16 * ks + 8 * hh);

  f32x16 o[NQT][VT];
  f32x16 nm[NQT];
  float mrun[NQT], lrun[NQT];
#pragma unroll
  for (int qt = 0; qt < NQT; ++qt) {
    mrun[qt] = m_init; lrun[qt] = l_init;
#pragma unroll
    for (int i = 0; i < 16; ++i) nm[qt][i] = -m_init;
#pragma unroll
    for (int vt = 0; vt < VT; ++vt)
#pragma unroll
      for (int i = 0; i < 16; ++i) o[qt][vt][i] = 0.f;
  }

  u32x4 stg0[NCH], stg1[NCH], stg2[NCH];
  {
    const size_t off = tile_off(0);
#pragma unroll
    for (int jj = 0; jj < NCH; ++jj) stg2[jj] = *(const u32x4*)(gbase + off + loff[jj]);
    {
      const size_t off1 = tile_off(min(1, ntiles - 1));
#pragma unroll
      for (int jj = 0; jj < NCH; ++jj) stg0[jj] = *(const u32x4*)(gbase + off1 + loff[jj]);
    }
    {
      const size_t off2 = tile_off(min(2, ntiles - 1));
#pragma unroll
      for (int jj = 0; jj < NCH; ++jj) stg1[jj] = *(const u32x4*)(gbase + off2 + loff[jj]);
    }
#pragma unroll
    for (int jj = 0; jj < NCH; ++jj) if (lval[jj]) *(u32x4*)(smem + ldst[jj]) = stg2[jj];
  }
  __syncthreads();

  const bool grpB = (w >= 4);
  const int sh = grpB ? 0 : 1;
  bf16x8 pf[NQT][2][2];
  f32x16 s[NQT][2];
  bool pf_ok = false, s_ok = false;
#define SB_ __builtin_amdgcn_sched_barrier(0)
  constexpr int CH = KST / 2;

  auto tile_active = [&](int ti) -> bool {
    bool a = (ti >= 0) && (ti < ntiles);
    if (MODE == 1 && !plain && ti >= 4) { const int R = na_rlo + (ti - 4); a = a && (R >= na_rs) && (R < na_rs + 8); }
    return a;
  };
  auto do_pv = [&](const char* vbuf) {
    s16x4 va[2][VT][2];
    const char* vb0 = vbuf + C::VOFF + (4 * hh + q4) * C::VS + (16 * g1 + 4 * p4) * 2;
#pragma unroll
    for (int vt = 0; vt < VT; ++vt) {
      va[0][vt][0] = __builtin_amdgcn_ds_read_tr16_b64_v4i16((LAS s16x4*)(vb0 + 64 * vt));
      va[0][vt][1] = __builtin_amdgcn_ds_read_tr16_b64_v4i16((LAS s16x4*)(vb0 + 64 * vt + 8 * C::VS));
    }
#pragma unroll
    for (int g = 0; g < 4; ++g) {
      if (g + 1 < 4) {
#pragma unroll
        for (int vt = 0; vt < VT; ++vt) {
          va[(g + 1) & 1][vt][0] = __builtin_amdgcn_ds_read_tr16_b64_v4i16((LAS s16x4*)(vb0 + 16 * (g + 1) * C::VS + 64 * vt));
          va[(g + 1) & 1][vt][1] = __builtin_amdgcn_ds_read_tr16_b64_v4i16((LAS s16x4*)(vb0 + (16 * (g + 1) + 8) * C::VS + 64 * vt));
        }
      }
      SB_;
#pragma unroll
      for (int vt = 0; vt < VT; ++vt) {
        const bf16x8 vfrag = __builtin_shufflevector(va[g & 1][vt][0], va[g & 1][vt][1], 0, 1, 2, 3, 4, 5, 6, 7);
#pragma unroll
        for (int qt = 0; qt < NQT; ++qt) o[qt][vt] = __builtin_amdgcn_mfma_f32_32x32x16_bf16(vfrag, pf[qt][g >> 1][g & 1], o[qt][vt], 0, 0, 0);
      }
      SB_;
    }
  };
  auto do_s = [&](const char* kbuf) {
    bf16x8 ka[2][CH];
    const char* kb0 = kbuf + c * C::KS + (8 * hh) * 2;
#pragma unroll
    for (int k = 0; k < CH; ++k) ka[0][k] = *(const bf16x8*)(kb0 + 32 * k);
#pragma unroll
    for (int j = 0; j < 4; ++j) {
      if (j + 1 < 4) {
#pragma unroll
        for (int k = 0; k < CH; ++k) ka[(j + 1) & 1][k] = *(const bf16x8*)(kb0 + 32 * ((j + 1) >> 1) * C::KS + 32 * (((j + 1) & 1) * CH + k));
      }
      SB_;
#pragma unroll
      for (int k = 0; k < CH; ++k)
#pragma unroll
        for (int qt = 0; qt < NQT; ++qt)
          s[qt][j >> 1] = __builtin_amdgcn_mfma_f32_32x32x16_bf16(ka[j & 1][k], qf[qt][(j & 1) * CH + k], (k == 0 && (j & 1) == 0) ? nm[qt] : s[qt][j >> 1], 0, 0, 0);
      SB_;
    }
  };
  auto do_sm = [&](int ti) {
    const int na_dr = na_rlo + (ti - 4) - na_r + 7;
#pragma unroll
    for (int qt = 0; qt < NQT; ++qt) {
      if (MODE == 1 && !plain && ti >= 4) {
        const int qs = clampi(na_qc - 8, 0, 48);
        const float* bb = (const float*)(smem + ATT_BIAS_OFF) + (na_dr * 31 + 15 - na_qc);
#pragma unroll
        for (int mt = 0; mt < 2; ++mt)
#pragma unroll
          for (int i = 0; i < 16; ++i) {
            const int kidx = 32 * mt + crow(i, hh);
            const bool ok = (unsigned)(kidx - qs) < 16u;
            s[qt][mt][i] = ok ? s[qt][mt][i] + bb[kidx] : -1e30f;
          }
      }
      if (MODE == 2 && ti >= 4) {
        const int dbase = 64 * (swa_tlo + ti - 4) - (32 * swa_j + c) + 128;
#pragma unroll
        for (int mt = 0; mt < 2; ++mt)
#pragma unroll
          for (int i = 0; i < 16; ++i) {
            const int kidx = 32 * mt + crow(i, hh);
            const bool ok = (unsigned)(dbase + kidx) <= 256u;
            s[qt][mt][i] = ok ? s[qt][mt][i] : -1e30f;
          }
      }
      float ls = 0.f;
#pragma unroll
      for (int mt = 0; mt < 2; ++mt) {
        float p[16];
#pragma unroll
        for (int i = 0; i < 16; ++i) { p[i] = __builtin_amdgcn_exp2f(s[qt][mt][i]); ls += p[i]; }
#pragma unroll
        for (int sp = 0; sp < 2; ++sp) {
          u32x4 pk = {pk2(p[8 * sp], p[8 * sp + 1]), pk2(p[8 * sp + 2], p[8 * sp + 3]), pk2(p[8 * sp + 4], p[8 * sp + 5]), pk2(p[8 * sp + 6], p[8 * sp + 7])};
          pf[qt][mt][sp] = __builtin_bit_cast(bf16x8, pk);
        }
      }
      const bool force = (MODE != 2) && (ti == 0);
      if (force || __any(!(ls < 1.0e18f))) {
        float mx = -1e30f;
#pragma unroll
        for (int mt = 0; mt < 2; ++mt)
#pragma unroll
          for (int i = 0; i < 16; ++i) mx = fmaxf(mx, s[qt][mt][i]);
        mx = fmaxf(mx, __shfl_xor(mx, 32));
        const float mraw = mx + mrun[qt];
        const float mnew = force ? mraw : fmaxf(mrun[qt], mraw);
        const float delta = mnew - mrun[qt];
        const float alpha = force ? 0.f : __builtin_amdgcn_exp2f(-delta);
        mrun[qt] = mnew;
        lrun[qt] *= alpha;
#pragma unroll
        for (int vt = 0; vt < VT; ++vt)
#pragma unroll
          for (int i = 0; i < 16; ++i) o[qt][vt][i] *= alpha;
#pragma unroll
        for (int i = 0; i < 16; ++i) nm[qt][i] = -mnew;
        ls = 0.f;
#pragma unroll
        for (int mt = 0; mt < 2; ++mt) {
          float p[16];
#pragma unroll
          for (int i = 0; i < 16; ++i) { p[i] = __builtin_amdgcn_exp2f(s[qt][mt][i] - delta); ls += p[i]; }
#pragma unroll
          for (int sp = 0; sp < 2; ++sp) {
            u32x4 pk = {pk2(p[8 * sp], p[8 * sp + 1]), pk2(p[8 * sp + 2], p[8 * sp + 3]), pk2(p[8 * sp + 4], p[8 * sp + 5]), pk2(p[8 * sp + 6], p[8 * sp + 7])};
            pf[qt][mt][sp] = __builtin_bit_cast(bf16x8, pk);
          }
        }
      }
      lrun[qt] += ls;
    }
  };

  auto step = [&](int t, u32x4 (&sl)[NCH], u32x4 (&ss)[NCH]) {
    const int tt = t + sh;
    const char* cur = smem + (tt & 3) * ABUF;
    const char* prv = smem + ((tt - 1) & 3) * ABUF;
    char* nxt = smem + ((t + 2) & 3) * ABUF;
    {
      const size_t off = tile_off(min(t + 4, ntiles - 1));
#pragma unroll
      for (int jj = 0; jj < NCH; ++jj) sl[jj] = *(const u32x4*)(gbase + off + loff[jj]);
    }
    const bool active = tile_active(tt);
    if (!grpB) {
      if (pf_ok) do_pv(prv);
      pf_ok = active;
      if (active) { do_s(cur); do_sm(tt); }
    } else {
      if (s_ok) { do_sm(tt - 1); do_pv(prv); }
      s_ok = active;
      if (active) do_s(cur);
    }
    if (t + 2 < ntiles) {
#pragma unroll
      for (int jj = 0; jj < NCH; ++jj) if (lval[jj]) *(u32x4*)(nxt + ldst[jj]) = ss[jj];
    }
    __syncthreads();
  };
  for (int t = -1; t <= ntiles; t += 3) { step(t, stg2, stg0); step(t + 1, stg0, stg1); step(t + 2, stg1, stg2); }
#pragma unroll
  for (int qt = 0; qt < NQT; ++qt) {
    const float lt = lrun[qt] + __shfl_xor(lrun[qt], 32);
    const float inv = 1.f / lt;
#pragma unroll
    for (int vt = 0; vt < VT; ++vt)
#pragma unroll
      for (int g = 0; g < 4; ++g) {
        const f32x16& ov = o[qt][vt];
        *(u32x2*)(optr[qt] + 32 * vt + 8 * g + 4 * hh) =
            (u32x2){pk2(ov[4 * g] * inv, ov[4 * g + 1] * inv), pk2(ov[4 * g + 2] * inv, ov[4 * g + 3] * inv)};
      }
  }
}

constexpr int NPHASE = 18;
#ifndef REP_ATT
#define REP_ATT 1
#endif
#ifndef REP_GEMM
#define REP_GEMM 1
#endif
constexpr int LDS_BYTES = GEMM_LDS;
#define XB_TMO      128
#define XB_XCNT(j)  (256  + 64 * (j))
#define XB_XSUB(j)  (1280 + 64 * (j))
#define XB_XGEN(j)  (2304 + 64 * (j))
#define XB_TOP      3328
#define XB_TOPGEN   3392
#define XB_SPIN_CAP (1u << 21)
DI unsigned xb_ld(unsigned* p) { return __hip_atomic_load(p, __ATOMIC_RELAXED, __HIP_MEMORY_SCOPE_AGENT); }
DI unsigned xb_add(unsigned* p, unsigned v) { return __hip_atomic_fetch_add(p, v, __ATOMIC_RELAXED, __HIP_MEMORY_SCOPE_AGENT); }
DI unsigned xb_xcc_id() { return (unsigned)__builtin_amdgcn_s_getreg((3 << 11) | 20) & 0xFu; }
#define XB_SPIN(cond, bar) do { unsigned _sp = 0; while (cond) { __builtin_amdgcn_s_sleep(1); \
    if ((++_sp & 255u) == 0u) { if (xb_ld(&(bar)[XB_TMO])) break; if (_sp > XB_SPIN_CAP) { atomicAdd(&(bar)[XB_TMO], 1u); break; } } } } while (0)
DI void xcd_barrier_complete(unsigned* bar, unsigned x, unsigned G, unsigned& nloc, unsigned& nx) {
  unsigned sum, cnt, mine, sp = 0u;
  for (;;) {
    sum = 0u; cnt = 0u; mine = 0u;
#pragma unroll
    for (unsigned j = 0; j < 16; ++j) { const unsigned c = xb_ld(&bar[XB_XCNT(j)]); sum += c; cnt += (c > 0u) ? 1u : 0u; mine = (j == x) ? c : mine; }
    if (sum == G) break;
    __builtin_amdgcn_s_sleep(1);
    if ((++sp & 255u) == 0u) { if (xb_ld(&bar[XB_TMO])) break; if (sp > XB_SPIN_CAP) { atomicAdd(&bar[XB_TMO], 1u); break; } }
  }
  nloc = mine > 0u ? mine : 1u; nx = cnt > 0u ? cnt : 1u;
}
DI void grid_barrier(unsigned* bar, volatile LAS unsigned* st, const unsigned x, const int wid0) {
  PHASE_IDS;
  asm volatile("s_waitcnt vmcnt(0)" ::: "memory");
  __syncthreads();
  if (tid == 0) {
    __builtin_amdgcn_s_waitcnt(0);
    unsigned nloc = st[0], nx = st[1];
    if (nloc == 0u) { xcd_barrier_complete(bar, x, (unsigned)nb, nloc, nx); st[0] = nloc; st[1] = nx; }
    const unsigned old = xb_add(&bar[XB_XSUB(x)], 1u);
    const unsigned gen = old / nloc;
    if (old + 1u == (gen + 1u) * nloc) {
      __builtin_amdgcn_fence(__ATOMIC_RELEASE, "agent");
      asm volatile("s_waitcnt vmcnt(0)" ::: "memory");
      const unsigned og = xb_add(&bar[XB_TOP], 1u);
      const unsigned tg = og / nx;
      if (og + 1u == (tg + 1u) * nx) xb_add(&bar[XB_TOPGEN], 1u);
      else XB_SPIN(xb_ld(&bar[XB_TOPGEN]) == tg, bar);
      __builtin_amdgcn_fence(__ATOMIC_ACQUIRE, "agent");
      xb_add(&bar[XB_XGEN(x)], 1u);
      asm volatile("s_waitcnt vmcnt(0)" ::: "memory");
    } else {
      XB_SPIN(xb_ld(&bar[XB_XGEN(x)]) == gen, bar);
      __builtin_amdgcn_fence(__ATOMIC_ACQUIRE, "agent");
      asm volatile("s_waitcnt vmcnt(0)" ::: "memory");
    }
  }
  __syncthreads();
}

__global__ void __launch_bounds__(512) fwd_megakernel(Params P_unused, int ph_lo, int ph_hi) {
  extern __shared__ __attribute__((aligned(16))) char smem[];
  cg::grid_group grid = cg::this_grid();
  typedef const __attribute__((address_space(4))) Params* KP;
  LAS unsigned char* ldsp = (LAS unsigned char*)smem;
  const int wid0 = __builtin_amdgcn_readfirstlane((int)threadIdx.x >> 6);
  __shared__ uint4 xb_words;
  volatile LAS unsigned* xb_st = (volatile LAS unsigned*)&xb_words;
  const unsigned xb_x = xb_xcc_id();
  if (threadIdx.x == 0) {
    xb_words = make_uint4(0u, 0u, 0u, 0u);
    KP kp0 = (KP)__builtin_amdgcn_kernarg_segment_ptr();
    (void)xb_add(&((unsigned*)(kp0->ws + MISC_BAR))[XB_XCNT(xb_x)], 1u);
  }
  __syncthreads();
  if (ph_hi > 1000) grid.sync();
#define PH_BEGIN KP kp_ = (KP)__builtin_amdgcn_kernarg_segment_ptr(); asm volatile("" : "+s"(kp_)); const Params& P = *(const Params*)kp_; \
  char* ws = P.ws; const float* modv = (const float*)(ws + MISC_MODV); float* h = (float*)(ws + H_OFF); \
  bf16_t* abuf = (bf16_t*)(ws + A_OFF); bf16_t* sbuf = (bf16_t*)(ws + S_OFF); (void)modv; (void)h; (void)abuf; (void)sbuf;
  if (ph_lo <= 0 && 0 < ph_hi) {
    PH_BEGIN
    prep_phase(P, smem, wid0);
    if (0 + 1 < ph_hi) grid_barrier((unsigned*)(ws + MISC_BAR), xb_st, xb_x, wid0);
  }
  if (ph_lo <= 1 && 1 < ph_hi) {
    PH_BEGIN
    norm_phase(P.x, P.ctx, modv, 0, 1024, abuf, T_ALL, wid0);
    if (1 + 1 < ph_hi) grid_barrier((unsigned*)(ws + MISC_BAR), xb_st, xb_x, wid0);
  }
  if (ph_lo <= 2 && 2 < ph_hi) {
    PH_BEGIN
    for (int rep_ = 0; rep_ < REP_GEMM; ++rep_) { __syncthreads(); EpiArgs e{}; e.out = sbuf; e.ldo = 2048; e.qscale = 0.125f * LOG2E; e.qs_lo = 416; e.qs_hi = 928; gemm_phase<EPI_BF16>(abuf, (const bf16_t*)(ws + W_IN0), T_ALL, 2048, 1024, e, ldsp, wid0); }
    if (2 + 1 < ph_hi) grid_barrier((unsigned*)(ws + MISC_BAR), xb_st, xb_x, wid0);
  }
  if (ph_lo <= 3 && 3 < ph_hi) {
    PH_BEGIN
    mla_prep_phase(P, wid0);
    if (3 + 1 < ph_hi) grid_barrier((unsigned*)(ws + MISC_BAR), xb_st, xb_x, wid0);
  }
  if (ph_lo <= 4 && 4 < ph_hi) {
    PH_BEGIN
    { EpiArgs e{}; e.out = ws + QMLA_OFF; e.ldo = 768; e.rope = (const float*)(ws + MISC_ROPEM); e.qscale = 0.10206207261596575f * LOG2E; e.qs_lo = 0; e.qs_hi = 768;
      gemm_phase<EPI_ROPE_MLA>((const bf16_t*)(ws + QN_OFF), (const bf16_t*)(ws + W_Q), T_ALL, 768, 256, e, ldsp, wid0);
      EpiArgs e2{}; e2.out = ws + KVF_OFF; e2.ldo = 1280; __syncthreads();
      gemm_phase<EPI_KVF>((const bf16_t*)(ws + A2_OFF), (const bf16_t*)(ws + W_KV), T_ALL, 1280, 256, e2, ldsp, wid0); }
    if (4 + 1 < ph_hi) grid_barrier((unsigned*)(ws + MISC_BAR), xb_st, xb_x, wid0);
  }
  if (ph_lo <= 5 && 5 < ph_hi) {
    PH_BEGIN
    PHASE_IDS;
    for (int rep_ = 0; rep_ < REP_ATT; ++rep_)
    {
      for (int it = bid; it < 1056; it += nb) attn_item<0>(P, it, smem, tid);
      asm volatile("" ::: "memory");
      for (int it = bid; it < 1056; it += nb) attn_item<1>(P, it, smem, opq_v(tid));
    }
    if (5 + 1 < ph_hi) grid_barrier((unsigned*)(ws + MISC_BAR), xb_st, xb_x, wid0);
  }
  if (ph_lo <= 6 && 6 < ph_hi) {
    PH_BEGIN
    for (int rep_ = 0; rep_ < REP_GEMM; ++rep_) { __syncthreads(); EpiArgs e{}; e.out = h; e.hin_lat = P.x; e.hin_ctx = P.ctx; e.gate = modv + 2048;
                gemm_phase<EPI_RESID>((const bf16_t*)(ws + ATTO_OFF), (const bf16_t*)(ws + W_OUT0), T_LAT, 1024, 1024, e, ldsp, wid0);
                EpiArgs e2{}; e2.out = ws + PART_OFF; __syncthreads();
                gemm_phase<EPI_F32P>((const bf16_t*)(ws + ATTO_OFF) + (size_t)T_LAT * 1024, (const bf16_t*)(ws + W_OUT0), T_CTX, 1024, 1024, e2, ldsp, wid0, 4); }
    if (6 + 1 < ph_hi) grid_barrier((unsigned*)(ws + MISC_BAR), xb_st, xb_x, wid0);
  }
  if (ph_lo <= 7 && 7 < ph_hi) {
    PH_BEGIN
    norm_phase(h, P.ctx, modv, 3072, 4096, abuf, T_ALL, wid0, (const float*)(ws + PART_OFF), 4, modv + 2048, h + (size_t)T_LAT * DM);
    if (7 + 1 < ph_hi) grid_barrier((unsigned*)(ws + MISC_BAR), xb_st, xb_x, wid0);
  }
  if (ph_lo <= 8 && 8 < ph_hi) {
    PH_BEGIN
    for (int rep_ = 0; rep_ < REP_GEMM; ++rep_) { __syncthreads(); EpiArgs e{}; e.out = sbuf; e.ldo = DFF; gemm_phase<EPI_SWIGLU>(abuf, (const bf16_t*)(ws + W_GU0), T_ALL, 2 * DFF, 1024, e, ldsp, wid0); }
    if (8 + 1 < ph_hi) grid_barrier((unsigned*)(ws + MISC_BAR), xb_st, xb_x, wid0);
  }
  if (ph_lo <= 9 && 9 < ph_hi) {
    PH_BEGIN
    { EpiArgs e{}; e.out = h; e.hin_lat = h; e.hin_ctx = h + (size_t)T_LAT * DM; e.gate = modv + 5120;
                gemm_phase<EPI_RESID>(sbuf, (const bf16_t*)(ws + W_DN0), T_LAT, 1024, DFF, e, ldsp, wid0);
                EpiArgs e2{}; e2.out = ws + PART_OFF; __syncthreads();
                gemm_phase<EPI_F32P>(sbuf + (size_t)T_LAT * DFF, (const bf16_t*)(ws + W_DN0), T_CTX, 1024, DFF, e2, ldsp, wid0, 11); }
    if (9 + 1 < ph_hi) grid_barrier((unsigned*)(ws + MISC_BAR), xb_st, xb_x, wid0);
  }
  if (ph_lo <= 10 && 10 < ph_hi) {
    PH_BEGIN
    norm_phase(h, h + (size_t)T_LAT * DM, modv + 5 * 6144, 0, 1024, abuf, T_ALL, wid0, (const float*)(ws + PART_OFF), 11, modv + 5120, h + (size_t)T_LAT * DM);
    if (10 + 1 < ph_hi) grid_barrier((unsigned*)(ws + MISC_BAR), xb_st, xb_x, wid0);
  }
  if (ph_lo <= 11 && 11 < ph_hi) {
    PH_BEGIN
    for (int rep_ = 0; rep_ < REP_GEMM; ++rep_) { __syncthreads(); EpiArgs e{}; e.out = sbuf; e.ldo = 1280; e.rope = (const float*)(ws + MISC_ROPES); e.qscale = 0.125f * LOG2E; e.qs_lo = 0; e.qs_hi = 1024;
                 gemm_phase<EPI_ROPE_SWA>(abuf, (const bf16_t*)(ws + W_IN1), T_ALL, 1280, 1024, e, ldsp, wid0); }
    if (11 + 1 < ph_hi) grid_barrier((unsigned*)(ws + MISC_BAR), xb_st, xb_x, wid0);
  }
  if (ph_lo <= 12 && 12 < ph_hi) {
    PH_BEGIN
    PHASE_IDS;
    for (int it = bid; it < 2048; it += nb) attn_item<2>(P, it, smem, tid);
    if (12 + 1 < ph_hi) grid_barrier((unsigned*)(ws + MISC_BAR), xb_st, xb_x, wid0);
  }
  if (ph_lo <= 13 && 13 < ph_hi) {
    PH_BEGIN
    { EpiArgs e{}; e.out = h; e.hin_lat = h; e.hin_ctx = h + (size_t)T_LAT * DM; e.gate = modv + 5 * 6144 + 2048;
                 gemm_phase<EPI_RESID>((const bf16_t*)(ws + O1_OFF), (const bf16_t*)(ws + W_OUT1), T_LAT, 1024, 1024, e, ldsp, wid0); }
    if (13 + 1 < ph_hi) grid_barrier((unsigned*)(ws + MISC_BAR), xb_st, xb_x, wid0);
  }
  if (ph_lo <= 14 && 14 < ph_hi) {
    PH_BEGIN
    norm_phase(h, h + (size_t)T_LAT * DM, modv + 5 * 6144, 3072, 4096, abuf, T_LAT, wid0);
    if (14 + 1 < ph_hi) grid_barrier((unsigned*)(ws + MISC_BAR), xb_st, xb_x, wid0);
  }
  if (ph_lo <= 15 && 15 < ph_hi) {
    PH_BEGIN
    for (int rep_ = 0; rep_ < REP_GEMM; ++rep_) { __syncthreads(); EpiArgs e{}; e.out = sbuf; e.ldo = DFF; gemm_phase<EPI_SWIGLU>(abuf, (const bf16_t*)(ws + W_GU1), T_LAT, 2 * DFF, 1024, e, ldsp, wid0); }
    if (15 + 1 < ph_hi) grid_barrier((unsigned*)(ws + MISC_BAR), xb_st, xb_x, wid0);
  }
  if (ph_lo <= 16 && 16 < ph_hi) {
    PH_BEGIN
    { EpiArgs e{}; e.out = abuf; e.ldo = 1024;
                 gemm_phase<EPI_BF16>(sbuf, (const bf16_t*)(ws + W_DN1), T_LAT, 1024, DFF, e, ldsp, wid0); }
    if (16 + 1 < ph_hi) grid_barrier((unsigned*)(ws + MISC_BAR), xb_st, xb_x, wid0);
  }
  if (ph_lo <= 17 && 17 < ph_hi) {
    PH_BEGIN
    final_norm_phase(h, abuf, modv + 5 * 6144 + 5120, P.final_norm, P.out, wid0);
    if (17 + 1 < ph_hi) grid_barrier((unsigned*)(ws + MISC_BAR), xb_st, xb_x, wid0);
  }
}

extern "C" void kernel_launch(void* const* d_in, const int* in_sizes, int n_in, void* d_out, int out_size, void* d_ws, size_t ws_size,
                              hipStream_t stream) {
  static int grid_blocks = 0;
  if (grid_blocks == 0) {
    if (n_in != 20 || ws_size < WS_END) { fprintf(stderr, "kernel_launch: unexpected n_in %d / ws_size %zu (need %zu)\n", n_in, ws_size, (size_t)WS_END); grid_blocks = -1; return; }
    int dev = 0, cus = 0, per_cu = 0;
    hipGetDevice(&dev);
    hipDeviceGetAttribute(&cus, hipDeviceAttributeMultiprocessorCount, dev);
    hipFuncSetAttribute((const void*)fwd_megakernel, hipFuncAttributeMaxDynamicSharedMemorySize, LDS_BYTES);
    hipOccupancyMaxActiveBlocksPerMultiprocessor(&per_cu, (const void*)fwd_megakernel, 512, LDS_BYTES);
    if (per_cu < 1) { fprintf(stderr, "kernel_launch: occupancy query says %d blocks per CU\n", per_cu); per_cu = 1; }
    grid_blocks = cus;
    (void)hipGetLastError();
  }
  if (grid_blocks < 0) return;
  Params p{};
  const float** pp = (const float**)&p;
  for (int i = 0; i < 20; ++i) pp[i] = (const float*)d_in[i];
  p.out = (float*)d_out; p.ws = (char*)d_ws;
  hipMemsetAsync((char*)d_ws + MISC, 0, MiB, stream);
  int lo = 0, hi = NPHASE;
  void* args[] = {&p, &lo, &hi};
  hipError_t e = hipLaunchCooperativeKernel((const void*)fwd_megakernel, dim3(grid_blocks), dim3(512), args, LDS_BYTES, stream);
  if (e != hipSuccess) fprintf(stderr, "cooperative launch failed: %s (grid %d)\n", hipGetErrorString(e), grid_blocks);
}
```

```cpp
#include <hip/hip_runtime.h>
#include <hip/hip_cooperative_groups.h>
#include <cstdio>
namespace cg = cooperative_groups;

#define DI __device__ __forceinline__
typedef unsigned short bf16_t;
typedef short bf16x8 __attribute__((ext_vector_type(8)));
typedef short s16x4 __attribute__((ext_vector_type(4)));
typedef float f32x2 __attribute__((ext_vector_type(2)));
typedef float f32x4 __attribute__((ext_vector_type(4)));
typedef float f32x16 __attribute__((ext_vector_type(16)));
typedef __bf16 bf16x2_t __attribute__((ext_vector_type(2)));
typedef unsigned u32x2 __attribute__((ext_vector_type(2)));
typedef unsigned u32x4 __attribute__((ext_vector_type(4)));
#define LAS __attribute__((address_space(3)))

DI int opq_v(int x) { asm volatile("" : "+v"(x)); return x; }
DI int opq_s(int x) { asm volatile("" : "+s"(x)); return x; }
#define PHASE_IDS const int tid = opq_v((opq_s(wid0) << 6) | (int)__builtin_amdgcn_mbcnt_hi((unsigned)opq_s(-1), __builtin_amdgcn_mbcnt_lo((unsigned)opq_s(-1), 0u))); const int bid = opq_s((int)blockIdx.x); const int nb = opq_s((int)gridDim.x); (void)tid; (void)bid; (void)nb
DI unsigned pk2(float a, float b) { f32x2 v = {a, b}; return __builtin_bit_cast(unsigned, __builtin_convertvector(v, bf16x2_t)); }
DI float bflo(unsigned u) { return __uint_as_float(u << 16); }
DI float bfhi(unsigned u) { return __uint_as_float(u & 0xffff0000u); }

constexpr int T_LAT = 32768, T_CTX = 1024, T_ALL = 33792, DM = 1024, SEQ = 8192, NCTX = 256, NKEY = 8448;
constexpr int DFF = 2816;
constexpr float EPS = 1e-6f, LOG2E = 1.4426950408889634f;

constexpr size_t MiB = 1u << 20;
constexpr size_t W_IN0 = 0, W_Q = 4 * MiB, W_KV = 4 * MiB + 384 * 1024, W_OUT0 = 5 * MiB, W_GU0 = 8 * MiB, W_GU1 = 19 * MiB, W_DN0 = 30 * MiB, W_DN1 = 36 * MiB,
                 W_IN1 = 42 * MiB, W_OUT1 = 45 * MiB;
constexpr size_t MISC = 47 * MiB;
constexpr size_t MISC_MODV = MISC;
constexpr size_t MISC_ROPEM = MISC + 256 * 1024;
constexpr size_t MISC_ROPES = MISC + 272 * 1024;
constexpr size_t MISC_BAR = MISC + 512 * 1024;
constexpr size_t H_OFF = 48 * MiB;
constexpr size_t QMLA_OFF = H_OFF;
constexpr size_t KVF_OFF = H_OFF + 50 * MiB;
constexpr size_t ATTO_OFF = 184 * MiB;
constexpr size_t QN_OFF = 412 * MiB;
constexpr size_t A2_OFF = 429 * MiB;
constexpr size_t A_OFF = 180 * MiB;
constexpr size_t S_OFF = 279 * MiB;
constexpr size_t O1_OFF = S_OFF + 83 * MiB;
constexpr size_t G1_OFF = 246 * MiB;
constexpr size_t D13_OFF = 440 * MiB;
constexpr size_t PART_OFF = 461 * MiB;
constexpr size_t WS_END = 505 * MiB;

struct Params {
  const float *x, *c, *ctx, *c_ctx, *mod_w, *mod_b, *even_w_in, *q_norm, *kv_norm, *w_q_up, *w_uk, *w_uv, *rel_bias, *even_w_out,
      *odd_w_in, *sinks, *odd_w_out, *w_gu, *w_dn, *final_norm;
  float* out;
  char* ws;
};

constexpr int BM = 256, BK = 64, HALF = 128, HT = HALF * BK, NXCD = 8, WGM = 8;
constexpr int GEMM_LDS = 8 * HT * 2;

DI int lds_byte(int r, int c) {
  int st = (r >> 4) * 2 + (c >> 5), rr = r & 15, cc = c & 31, ob = rr * 64 + cc * 2;
  return st * 1024 + (ob ^ (((ob >> 9) & 1) << 5));
}
DI void stage_rc(int b, int& R, int& C) {
  int st = b / 1024, sb = b % 1024, swz = sb ^ (((sb >> 9) & 1) << 5);
  R = (st >> 1) * 16 + swz / 64; C = (st & 1) * 32 + (swz % 64) / 2;
}

enum { EPI_BF16 = 0, EPI_ROPE_MLA = 1, EPI_ROPE_SWA = 2, EPI_RESID = 3, EPI_SWIGLU = 4, EPI_F32P = 5, EPI_KVF = 6 };
struct EpiArgs {
  void* out; int ldo;
  const float* hin_lat; const float* hin_ctx;
  const float* gate;
  const float* rope;
  float qscale; int qs_lo, qs_hi;
};

template <int EPI>
DI void gemm_phase(const bf16_t* __restrict__ A, const bf16_t* __restrict__ Bt, int M, int N, int K, const EpiArgs e, LAS unsigned char* lds, const int wid0, const int ksplit = 1) {
  PHASE_IDS;
  const int wid = __builtin_amdgcn_readfirstlane(tid >> 6), lane = tid & 63, wr = wid >> 2, wc = wid & 3, fr = lane & 15, fq = lane >> 4;
  const int kloop = K / ksplit;
  const int nt = kloop / BK;
  const int nM = M / BM, nN = N / BM, ntile = nM * nN, nwg = ntile * ksplit;
  unsigned voff[2];
#pragma unroll
  for (int i = 0; i < 2; ++i) { int R, C; stage_rc(tid * 16 + i * 8192, R, C); voff[i] = (unsigned)(R * K + C) * 2u; }
  const size_t kstep = (size_t)(BK * 2);
  const size_t hstep = (size_t)HALF * K * 2;
  const size_t tstep = 2 * hstep;
  const unsigned ldsw = (unsigned)wid * 1024u;
  const int aoff = lds_byte(wr * 64 + fr, fq * 8), boff = lds_byte(wc * 32 + fr, fq * 8);
  constexpr int HTB = HALF * BK * 2;
#define PG8_SA(b, h) (((b) * 2 + (h)) * HTB)
#define PG8_SB(b, h) ((4 + (b) * 2 + (h)) * HTB)
#define PG8_STAGE(bufoff, gbase) do { _Pragma("unroll") for (int _i = 0; _i < 2; ++_i) \
    __builtin_amdgcn_global_load_lds((const unsigned*)((const char*)(gbase) + voff[_i]), (LAS unsigned*)(lds + (bufoff) + ldsw + _i * 8192), 16, 0, 0); } while (0)
#define PG8_LDA(dst, b, h) do { _Pragma("unroll") for (int m = 0; m < 4; ++m) _Pragma("unroll") for (int k = 0; k < 2; ++k) dst[m][k] = *(const LAS bf16x8*)(lds + PG8_SA(b, h) + aoff + m * 2048 + k * 1024); } while (0)
#define PG8_LDB(dst, b, h) do { _Pragma("unroll") for (int n = 0; n < 2; ++n) _Pragma("unroll") for (int k = 0; k < 2; ++k) dst[n][k] = *(const LAS bf16x8*)(lds + PG8_SB(b, h) + boff + n * 2048 + k * 1024); } while (0)
#define PG8_MMA(ai, bj, At_, Bt_) do { __builtin_amdgcn_s_setprio(1); _Pragma("unroll") for (int m = 0; m < 4; ++m) _Pragma("unroll") for (int n = 0; n < 2; ++n) _Pragma("unroll") for (int k = 0; k < 2; ++k) \
    acc[ai][bj][m][n] = __builtin_amdgcn_mfma_f32_16x16x32_bf16(Bt_[n][k], At_[m][k], acc[ai][bj][m][n], 0, 0, 0); __builtin_amdgcn_s_setprio(0); } while (0)
#define PG8_WAIT_V(n) asm volatile("s_waitcnt vmcnt(" #n ")" ::: "memory")
#define PG8_WAIT_L(n) asm volatile("s_waitcnt lgkmcnt(" #n ")" ::: "memory")
#define PG8_BAR __builtin_amdgcn_s_barrier()
#define PG8_SCHED __builtin_amdgcn_sched_barrier(0)
#define UNIT_OF(L_, pm_, pn_, ks_) do { ks_ = (L_) / ntile; int wgid = (L_) - ks_ * ntile; { const int q = ntile / NXCD, r = ntile % NXCD, xcd = wgid % NXCD, off = wgid / NXCD; \
      wgid = (xcd < r ? xcd * (q + 1) : r * (q + 1) + (xcd - r) * q) + off; } \
    const int nig = WGM * nN, gid = wgid / nig, fm = gid * WGM, gsz = (nM - fm) < WGM ? (nM - fm) : WGM; \
    pm_ = fm + ((wgid % nig) % gsz); pn_ = (wgid % nig) / gsz; } while (0)

  int L = bid;
  if (L >= nwg) return;
  int pm, pn, ksu, npm = 0, npn = 0, nksu = 0;
  UNIT_OF(L, pm, pn, ksu);
  f32x4 acc[2][2][4][2];
#pragma unroll
  for (int a = 0; a < 2; ++a)
#pragma unroll
    for (int b = 0; b < 2; ++b)
#pragma unroll
      for (int m = 0; m < 4; ++m)
#pragma unroll
        for (int n = 0; n < 2; ++n) acc[a][b][m][n] = (f32x4){0.f, 0.f, 0.f, 0.f};
  bf16x8 At[4][2], B0[2][2], B1[2][2];
  const char* cA = (const char*)A + (size_t)pm * tstep + (size_t)ksu * kloop * 2; const char* cB = (const char*)Bt + (size_t)pn * tstep + (size_t)ksu * kloop * 2;
  PG8_STAGE(PG8_SB(0, 0), cB); PG8_STAGE(PG8_SA(0, 0), cA); PG8_STAGE(PG8_SB(0, 1), cB + hstep); PG8_STAGE(PG8_SA(0, 1), cA + hstep);
  if (wr == 1) PG8_BAR;
  PG8_WAIT_V(4); PG8_BAR;
  PG8_STAGE(PG8_SB(1, 0), cB + kstep); PG8_STAGE(PG8_SA(1, 0), cA + kstep); PG8_STAGE(PG8_SB(1, 1), cB + hstep + kstep);
  PG8_WAIT_V(6); PG8_BAR;
  for (;;) {
    const int Ln = L + nb;
    const bool has_next = Ln < nwg;
    if (has_next) UNIT_OF(Ln, npm, npn, nksu);
    const char* nA = has_next ? (const char*)A + (size_t)npm * tstep + (size_t)nksu * kloop * 2 : cA; const char* nB = has_next ? (const char*)Bt + (size_t)npn * tstep + (size_t)nksu * kloop * 2 : cB;
    for (int t = 0; t < nt; t += 2) {
      const bool last = (t == nt - 2);
      const char* a1 = cA + (size_t)(t + 1) * kstep;
      const char* a2 = last ? nA : cA + (size_t)(t + 2) * kstep; const char* b2 = last ? nB : cB + (size_t)(t + 2) * kstep;
      const char* a3 = a2 + kstep; const char* b3 = b2 + kstep;
      PG8_LDB(B0, 0, 0); PG8_SCHED; PG8_LDA(At, 0, 0); PG8_STAGE(PG8_SA(1, 1), a1 + hstep);
      PG8_WAIT_L(8); PG8_BAR; PG8_WAIT_L(0); PG8_MMA(0, 0, At, B0); PG8_BAR; PG8_SCHED;
      PG8_LDB(B1, 0, 1); PG8_STAGE(PG8_SB(0, 0), b2);
      PG8_BAR; PG8_WAIT_L(0); PG8_MMA(0, 1, At, B1); PG8_BAR;
      PG8_LDA(At, 0, 1); PG8_STAGE(PG8_SA(0, 0), a2);
      PG8_BAR; PG8_WAIT_L(0); PG8_MMA(1, 0, At, B0); PG8_BAR; PG8_SCHED;
      PG8_STAGE(PG8_SB(0, 1), b2 + hstep);
      PG8_WAIT_V(6); PG8_BAR; PG8_MMA(1, 1, At, B1); PG8_BAR;
      PG8_LDB(B0, 1, 0); PG8_SCHED; PG8_LDA(At, 1, 0); PG8_STAGE(PG8_SA(0, 1), a2 + hstep);
      PG8_WAIT_L(8); PG8_BAR; PG8_WAIT_L(0); PG8_MMA(0, 0, At, B0); PG8_BAR; PG8_SCHED;
      PG8_LDB(B1, 1, 1); PG8_STAGE(PG8_SB(1, 0), b3);
      PG8_BAR; PG8_WAIT_L(0); PG8_MMA(0, 1, At, B1); PG8_BAR;
      PG8_LDA(At, 1, 1); PG8_STAGE(PG8_SA(1, 0), a3);
      PG8_BAR; PG8_WAIT_L(0); PG8_MMA(1, 0, At, B0); PG8_BAR; PG8_SCHED;
      PG8_STAGE(PG8_SB(1, 1), b3 + hstep);
      PG8_WAIT_V(6); PG8_BAR; PG8_MMA(1, 1, At, B1); PG8_BAR;
    }
    const int brow = pm * BM, bcol = pn * BM;
#pragma unroll
    for (int ai = 0; ai < 2; ++ai)
#pragma unroll
      for (int m = 0; m < 4; ++m) {
        const int row = brow + ai * HALF + wr * 64 + m * 16 + fr;
#pragma unroll
        for (int bj = 0; bj < 2; ++bj) {
          const int gcol0 = bcol + bj * HALF + wc * 32;
          f32x4 v0 = acc[ai][bj][m][0], v1 = acc[ai][bj][m][1];
          if (EPI == EPI_KVF) {
            const int b = (row < T_LAT) ? (row >> 13) : ((row - T_LAT) >> 8);
            const int key = (row < T_LAT) ? (NCTX + (row & (SEQ - 1))) : ((row - T_LAT) & 255);
            int hd, within;
            if (gcol0 < 768) { hd = gcol0 / 96; within = gcol0 - hd * 96; } else { hd = (gcol0 - 768) >> 6; within = 96 + ((gcol0 - 768) & 63); }
            bf16_t* o = (bf16_t*)e.out + ((size_t)(b * 8 + hd) * NKEY + key) * 160 + within + 4 * fq;
            *(u32x2*)o = (u32x2){pk2(v0[0], v0[1]), pk2(v0[2], v0[3])};
            *(u32x2*)(o + 16) = (u32x2){pk2(v1[0], v1[1]), pk2(v1[2], v1[3])};
          } else
          if (EPI == EPI_F32P) {
            float* o = (float*)e.out + ((size_t)ksu * M + row) * N + gcol0 + 4 * fq;
            *(f32x4*)o = v0; *(f32x4*)(o + 16) = v1;
          } else
          if (EPI == EPI_BF16 || EPI == EPI_ROPE_MLA || EPI == EPI_ROPE_SWA) {
            if (EPI != EPI_BF16) {
              bool isrope; int usecol, f0, nf;
              if (EPI == EPI_ROPE_MLA) { isrope = ((gcol0 >> 5) % 3) == 2; usecol = fq >> 1; f0 = (4 * fq) & 7; nf = 8; }
              else { isrope = gcol0 < 1152; usecol = (gcol0 >> 5) & 1; f0 = 4 * fq; nf = 16; }
              if (isrope && row < T_LAT) {
                const int s = row & (SEQ - 1), pos = usecol ? (s & 63) : (s >> 6);
                const f32x4* tp = (const f32x4*)(e.rope + (size_t)(pos * nf + f0) * 2);
                const f32x4 c01 = tp[0], c23 = tp[1];
                f32x4 a0 = v0, a1 = v1;
                v0[0] = a0[0] * c01[0] - a1[0] * c01[1]; v1[0] = a0[0] * c01[1] + a1[0] * c01[0];
                v0[1] = a0[1] * c01[2] - a1[1] * c01[3]; v1[1] = a0[1] * c01[3] + a1[1] * c01[2];
                v0[2] = a0[2] * c23[0] - a1[2] * c23[1]; v1[2] = a0[2] * c23[1] + a1[2] * c23[0];
                v0[3] = a0[3] * c23[2] - a1[3] * c23[3]; v1[3] = a0[3] * c23[3] + a1[3] * c23[2];
              }
            }
            if (gcol0 >= e.qs_lo && gcol0 < e.qs_hi) { v0 *= e.qscale; v1 *= e.qscale; }
            bf16_t* o = (bf16_t*)e.out + (size_t)row * e.ldo + gcol0 + 4 * fq;
            *(u32x2*)o = (u32x2){pk2(v0[0], v0[1]), pk2(v0[2], v0[3])};
            *(u32x2*)(o + 16) = (u32x2){pk2(v1[0], v1[1]), pk2(v1[2], v1[3])};
          } else if (EPI == EPI_RESID) {
            const float* hin = (row < T_LAT) ? e.hin_lat + (size_t)row * DM : e.hin_ctx + (size_t)(row - T_LAT) * DM;
            const int bb = (row < T_LAT) ? (row >> 13) : 4;
            const float* g = e.gate + bb * 6144;
            const int c0 = gcol0 + 4 * fq;
            float* o = (float*)e.out + (size_t)row * DM;
            f32x4 h0 = *(const f32x4*)(hin + c0), h1 = *(const f32x4*)(hin + c0 + 16);
            f32x4 g0 = *(const f32x4*)(g + c0), g1 = *(const f32x4*)(g + c0 + 16);
            *(f32x4*)(o + c0) = h0 + g0 * v0;
            *(f32x4*)(o + c0 + 16) = h1 + g1 * v1;
          } else {
            f32x4 r;
#pragma unroll
            for (int i = 0; i < 4; ++i) { const float gq = v0[i]; r[i] = gq * __builtin_amdgcn_rcpf(1.f + __builtin_amdgcn_exp2f(-LOG2E * gq)) * v1[i]; }
            bf16_t* o = (bf16_t*)e.out + (size_t)row * e.ldo + (gcol0 >> 1) + 4 * fq;
            *(u32x2*)o = (u32x2){pk2(r[0], r[1]), pk2(r[2], r[3])};
          }
        }
      }
    if (!has_next) break;
#pragma unroll
    for (int a = 0; a < 2; ++a)
#pragma unroll
      for (int b = 0; b < 2; ++b)
#pragma unroll
        for (int m = 0; m < 4; ++m)
#pragma unroll
          for (int n = 0; n < 2; ++n) acc[a][b][m][n] = (f32x4){0.f, 0.f, 0.f, 0.f};
    L = Ln; pm = npm; pn = npn; ksu = nksu; cA = nA; cB = nB;
  }
  PG8_WAIT_V(0);
  if (wr == 0) PG8_BAR;
  PG8_BAR;
#undef PG8_SA
#undef PG8_SB
#undef PG8_STAGE
#undef PG8_LDA
#undef PG8_LDB
#undef PG8_MMA
#undef UNIT_OF
}

DI int gu_perm(int n) { return (n < DFF) ? ((n >> 4) * 32 + (n & 15)) : (((n - DFF) >> 4) * 32 + 16 + ((n - DFF) & 15)); }
DI void tr_strip(const float* src, int ldsrc, int nvalid, bf16_t* dst, int lddst, int kcol0, int k0, int n0, int perm, float* tl, const int tid) {
  constexpr int TS = 257;
#pragma unroll
  for (int jj = 0; jj < 8; ++jj) {
    const int k = (tid >> 6) + 8 * jj, n = (tid & 63) * 4;
    f32x4 v = {0.f, 0.f, 0.f, 0.f};
    if (n0 + n < nvalid) v = *(const f32x4*)(src + (size_t)(k0 + k) * ldsrc + n0 + n);
    tl[k * TS + n] = v[0]; tl[k * TS + n + 1] = v[1]; tl[k * TS + n + 2] = v[2]; tl[k * TS + n + 3] = v[3];
  }
  __syncthreads();
#pragma unroll
  for (int jj = 0; jj < 4; ++jj) {
    const int idx = tid + 512 * jj, n = idx >> 3, kc = (idx & 7) * 8;
    float f[8];
#pragma unroll
    for (int j = 0; j < 8; ++j) f[j] = tl[(kc + j) * TS + n];
    const int nd = perm ? gu_perm(n0 + n) : (n0 + n);
    *(u32x4*)(dst + (size_t)nd * lddst + kcol0 + k0 + kc) = (u32x4){pk2(f[0], f[1]), pk2(f[2], f[3]), pk2(f[4], f[5]), pk2(f[6], f[7])};
  }
  __syncthreads();
}

DI void prep_phase(const Params& P, char* smem, const int wid0) {
  PHASE_IDS;
  float* tl = (float*)smem;
  char* ws = P.ws;
  constexpr int J_IN0 = 128, J_GU = 352, J_DN = 176, J_IN1 = 80, J_OUT1 = 64, J_OUT0B = 64;
  constexpr int J_TR = J_IN0 + 2 * J_GU + 2 * J_DN + J_IN1 + J_OUT1 + J_OUT0B;
  constexpr int J_QA = 384, J_QR = 640, J_OF = 0, J_MOD = 384, J_ROPE = 1;
  constexpr int J_ALL = J_TR + J_QA + J_QR + J_OF + J_MOD + J_ROPE;
  for (int job = bid; job < J_ALL; job += nb) {
    int j = job;
    if (j < J_TR) {
      if (j < J_IN0) { const int kt = j & 15, ns = j >> 4; tr_strip(P.even_w_in, 1952, 1952, (bf16_t*)(ws + W_IN0), 1024, 0, kt * 64, ns * 256, 0, tl, tid); continue; }
      j -= J_IN0;
      if (j < 2 * J_GU) { const int l = j / J_GU; j -= l * J_GU; const int kt = j & 15, ns = j >> 4;
        tr_strip(P.w_gu + (size_t)l * 1024 * 5632, 5632, 5632, (bf16_t*)(ws + (l ? W_GU1 : W_GU0)), 1024, 0, kt * 64, ns * 256, 1, tl, tid); continue; }
      j -= 2 * J_GU;
      if (j < 2 * J_DN) { const int l = j / J_DN; j -= l * J_DN; const int kt = j % 44, ns = j / 44;
        tr_strip(P.w_dn + (size_t)l * DFF * 1024, 1024, 1024, (bf16_t*)(ws + (l ? W_DN1 : W_DN0)), DFF, 0, kt * 64, ns * 256, 0, tl, tid); continue; }
      j -= 2 * J_DN;
      if (j < J_IN1) { const int kt = j & 15, ns = j >> 4; tr_strip(P.odd_w_in, 1280, 1280, (bf16_t*)(ws + W_IN1), 1024, 0, kt * 64, ns * 256, 0, tl, tid); continue; }
      j -= J_IN1;
      if (j < J_OUT1) { const int kt = j & 15, ns = j >> 4; tr_strip(P.odd_w_out, 1024, 1024, (bf16_t*)(ws + W_OUT1), 1024, 0, kt * 64, ns * 256, 0, tl, tid); continue; }
      j -= J_OUT1;
      { const int kt = j & 15, ns = j >> 4; tr_strip(P.even_w_out, 1024, 1024, (bf16_t*)(ws + W_OUT0), 1024, 0, kt * 64, ns * 256, 0, tl, tid); continue; }
    }
    j -= J_TR;
    if (j < J_QA) {
      const int o = j * 512 + tid, k = o & 255, r = o >> 8, h = r / 96, n = r - h * 96;
      int sc = n;
      if (n >= 64) { const int p = n - 64; sc = 64 + ((p < 8) ? p : (p < 16) ? (8 + p) : (p < 24) ? (p - 8) : p); }
      const float v = P.w_q_up[(size_t)k * 768 + h * 96 + sc] * P.q_norm[k];
      ((bf16_t*)(ws + W_Q))[(size_t)r * 256 + k] = (bf16_t)(pk2(v, 0.f) & 0xffff);
      continue;
    }
    j -= J_QA;
    if (j < J_QR) {
      const int o = j * 512 + tid, cidx = o & 255, r = o >> 8;
      float v = 0.f;
      if (r < 768) {
        const int h = r / 96, n = r - h * 96;
        if (n < 64) { if (cidx < 128) v = P.w_uk[((size_t)h * 128 + cidx) * 64 + n]; }
        else v = (cidx == 128 + (n - 64)) ? 1.f : 0.f;
      } else {
        const int rv = r - 768, h = rv >> 6, vv = rv & 63;
        if (cidx < 128) v = P.w_uv[((size_t)h * 128 + cidx) * 64 + vv];
      }
      ((bf16_t*)(ws + W_KV))[(size_t)r * 256 + cidx] = (bf16_t)(pk2(v, 0.f) & 0xffff);
      continue;
    }
    j -= J_QR;
    j -= J_OF;
    if (j < J_MOD) {
      const int l = j / 192, r = j % 192, kc = r / 12, jc = r % 12, col = jc * 512 + tid;
      float* sv = (float*)smem;
      __syncthreads();
      if (tid < 320) { const int bb = tid >> 6, k = kc * 64 + (tid & 63); const float v = (bb < 4) ? P.c[bb * 1024 + k] : P.c_ctx[k]; sv[tid] = v / (1.f + __expf(-v)); }
      __syncthreads();
      const float* w = P.mod_w + ((size_t)l * 1024 + kc * 64) * 6144 + col;
      float a0 = 0.f, a1 = 0.f, a2 = 0.f, a3 = 0.f, a4 = 0.f;
#pragma unroll 8
      for (int k = 0; k < 64; ++k) { const float wv = w[(size_t)k * 6144]; a0 += sv[k] * wv; a1 += sv[64 + k] * wv; a2 += sv[128 + k] * wv; a3 += sv[192 + k] * wv; a4 += sv[256 + k] * wv; }
      if (kc == 0) { const float b = P.mod_b[l * 6144 + col]; a0 += b; a1 += b; a2 += b; a3 += b; a4 += b; }
      float* mv = (float*)(ws + MISC_MODV) + (size_t)l * 5 * 6144 + col;
      unsafeAtomicAdd(mv, a0); unsafeAtomicAdd(mv + 6144, a1); unsafeAtomicAdd(mv + 2 * 6144, a2); unsafeAtomicAdd(mv + 3 * 6144, a3); unsafeAtomicAdd(mv + 4 * 6144, a4);
      __syncthreads();
      continue;
    }
    j -= J_MOD;
    {
      for (int i = tid; i < 128 * 24; i += 512) {
        const int pos = i / 24, f = i % 24;
        float inv; float* dst;
        if (f < 8) { inv = powf(10000.f, -(float)f / 8.f); dst = (float*)(ws + MISC_ROPEM) + (pos * 8 + f) * 2; }
        else { inv = powf(10000.f, -(float)(f - 8) / 16.f); dst = (float*)(ws + MISC_ROPES) + (pos * 16 + (f - 8)) * 2; }
        const float ang = (float)pos * inv;
        dst[0] = cosf(ang); dst[1] = sinf(ang);
      }
    }
  }
}

DI float wave_sum(float v) {
#pragma unroll
  for (int o = 32; o > 0; o >>= 1) v += __shfl_xor(v, o);
  return v;
}
DI void norm_phase(const float* h_lat, const float* h_ctx, const float* modl, int sh_off, int sc_off, bf16_t* a, int nrows, const int wid0,
                   const float* parts = nullptr, int nparts = 0, const float* gate = nullptr, float* hout_ctx = nullptr,
                   const bf16_t* dlt = nullptr, const float* dgate = nullptr) {
  PHASE_IDS;
  const int lane = tid & 63, gw = bid * 8 + (tid >> 6), nw = nb * 8;
  for (int row = gw; row < nrows; row += nw) {
    const float* src = (row < T_LAT) ? h_lat + (size_t)row * DM : h_ctx + (size_t)(row - T_LAT) * DM;
    const int bb = (row < T_LAT) ? (row >> 13) : 4;
    f32x4 v[4]; float ss = 0.f;
#pragma unroll
    for (int j = 0; j < 4; ++j) {
      v[j] = *(const f32x4*)(src + lane * 4 + 256 * j);
      if (dlt && row < T_LAT) {
        const u32x2 dd = *(const u32x2*)(dlt + (size_t)row * DM + lane * 4 + 256 * j);
        const f32x4 dv = {bflo(dd[0]), bfhi(dd[0]), bflo(dd[1]), bfhi(dd[1])};
        v[j] += *(const f32x4*)(dgate + bb * 6144 + lane * 4 + 256 * j) * dv;
      }
      if (parts && row >= T_LAT) {
        f32x4 ps = {0.f, 0.f, 0.f, 0.f};
        for (int s = 0; s < nparts; ++s) ps += *(const f32x4*)(parts + ((size_t)s * T_CTX + (row - T_LAT)) * DM + lane * 4 + 256 * j);
        v[j] += *(const f32x4*)(gate + 4 * 6144 + lane * 4 + 256 * j) * ps;
        *(f32x4*)(hout_ctx + (size_t)(row - T_LAT) * DM + lane * 4 + 256 * j) = v[j];
      }
      ss += v[j][0] * v[j][0] + v[j][1] * v[j][1] + v[j][2] * v[j][2] + v[j][3] * v[j][3];
    }
    ss = wave_sum(ss);
    const float r = rsqrtf(ss * (1.f / DM) + EPS);
    const float* sh = modl + bb * 6144 + sh_off; const float* sc = modl + bb * 6144 + sc_off;
#pragma unroll
    for (int j = 0; j < 4; ++j) {
      const int c = lane * 4 + 256 * j;
      const f32x4 s1 = *(const f32x4*)(sc + c), s0 = *(const f32x4*)(sh + c);
      f32x4 y = v[j] * r * (s1 + 1.f) + s0;
      *(u32x2*)(a + (size_t)row * DM + c) = (u32x2){pk2(y[0], y[1]), pk2(y[2], y[3])};
    }
  }
}
DI void final_norm_phase(const float* h, const bf16_t* d, const float* gate, const bf16_t* d2, const float* gate2, const float* gain, float* out, const int wid0) {
  PHASE_IDS;
  const int lane = tid & 63, gw = bid * 8 + (tid >> 6), nw = nb * 8;
  for (int row = gw; row < T_LAT; row += nw) {
    const float* src = h + (size_t)row * DM;
    const bf16_t* dsrc = d + (size_t)row * DM;
    const float* g = gate + (row >> 13) * 6144;
    const bf16_t* dsrc2 = d2 + (size_t)row * DM;
    const float* g2 = gate2 + (row >> 13) * 6144;
    f32x4 v[4]; float ss = 0.f;
#pragma unroll
    for (int j = 0; j < 4; ++j) {
      const int c = lane * 4 + 256 * j;
      const u32x2 dd = *(const u32x2*)(dsrc + c);
      const f32x4 dv = {bflo(dd[0]), bfhi(dd[0]), bflo(dd[1]), bfhi(dd[1])};
      const u32x2 ee = *(const u32x2*)(dsrc2 + c);
      const f32x4 ev = {bflo(ee[0]), bfhi(ee[0]), bflo(ee[1]), bfhi(ee[1])};
      v[j] = *(const f32x4*)(src + c) + *(const f32x4*)(g2 + c) * ev + *(const f32x4*)(g + c) * dv;
      ss += v[j][0] * v[j][0] + v[j][1] * v[j][1] + v[j][2] * v[j][2] + v[j][3] * v[j][3];
    }
    ss = wave_sum(ss);
    const float r = rsqrtf(ss * (1.f / DM) + EPS);
#pragma unroll
    for (int j = 0; j < 4; ++j) {
      const int c = lane * 4 + 256 * j;
      *(f32x4*)(out + (size_t)row * DM + c) = v[j] * r * *(const f32x4*)(gain + c);
    }
  }
}
DI void mla_prep_phase(const Params& P, const int wid0) {
  const bf16_t* p0 = (const bf16_t*)(P.ws + S_OFF);
  bf16_t* qn = (bf16_t*)(P.ws + QN_OFF);
  bf16_t* a2 = (bf16_t*)(P.ws + A2_OFF);
  const float* ropem = (const float*)(P.ws + MISC_ROPEM);
  PHASE_IDS;
  const int lane = tid & 63, gw = bid * 8 + (tid >> 6), nw = nb * 8;
  for (int row = gw; row < T_ALL; row += nw) {
    const bf16_t* src = p0 + (size_t)row * 2048;
    const u32x2 q = *(const u32x2*)(src + 4 * lane);
    const float q0 = bflo(q[0]), q1 = bfhi(q[0]), q2 = bflo(q[1]), q3 = bfhi(q[1]);
    const float rq = rsqrtf(wave_sum(q0 * q0 + q1 * q1 + q2 * q2 + q3 * q3) * (1.f / 256.f) + EPS);
    *(u32x2*)(qn + (size_t)row * 256 + 4 * lane) = (u32x2){pk2(q0 * rq, q1 * rq), pk2(q2 * rq, q3 * rq)};
    const unsigned kk = *(const unsigned*)(src + 256 + 2 * lane);
    const float k0 = bflo(kk), k1 = bfhi(kk);
    const float rk = rsqrtf(wave_sum(k0 * k0 + k1 * k1) * (1.f / 128.f) + EPS);
    const int s = (row < T_LAT) ? (row & (SEQ - 1)) : -1;
    bf16_t* dst = a2 + (size_t)row * 256;
    if (lane < 48) *(unsigned*)(dst + 160 + 2 * lane) = 0u;
    *(unsigned*)(dst + 2 * lane) = pk2(k0 * rk * P.kv_norm[2 * lane], k1 * rk * P.kv_norm[2 * lane + 1]);
    if (lane < 16) {
      const int i = lane, i1 = (i < 8) ? i : (8 + i), f = i & 7;
      float x1 = __uint_as_float((unsigned)src[384 + i1] << 16), x2 = __uint_as_float((unsigned)src[384 + i1 + 8] << 16);
      float o1 = x1, o2 = x2;
      if (s >= 0) {
        const int pos = (i < 8) ? (s >> 6) : (s & 63);
        const float cs = ropem[(pos * 8 + f) * 2], sn = ropem[(pos * 8 + f) * 2 + 1];
        o1 = x1 * cs - x2 * sn; o2 = x1 * sn + x2 * cs;
      }
      dst[128 + i] = (bf16_t)(pk2(o1, 0.f) & 0xffff);
      dst[144 + i] = (bf16_t)(pk2(o2, 0.f) & 0xffff);
    }
  }
}

template <int MODE> struct ACfg;
template <> struct ACfg<0> { static constexpr int DQK = 96, DV = 64, NQT = 1, KS = 208, VS = 192, VOFF = 13312, NCH = 3; };
template <> struct ACfg<1> { static constexpr int DQK = 64, DV = 64, NQT = 1, KS = 144, VS = 192, VOFF = 9216, NCH = 2; };
template <> struct ACfg<2> { static constexpr int DQK = 64, DV = 64, NQT = 1, KS = 144, VS = 192, VOFF = 9216, NCH = 2; };
constexpr int ABUF = 25600;
constexpr int ATT_BIAS_OFF = 4 * ABUF;

DI int crow(int i, int h) { return (i & 3) + 8 * (i >> 2) + 4 * h; }
DI int clampi(int v, int lo, int hi) { return v < lo ? lo : (v > hi ? hi : v); }

template <int MODE>
DI void attn_item(const Params& P, int item, char* smem, const int tid) {
  using C = ACfg<MODE>;
  constexpr int KST = C::DQK / 16, VT = C::DV / 32, NQT = C::NQT, NCH = C::NCH;
  const int w = tid >> 6, lane = tid & 63, c = lane & 31, hh = lane >> 5;
  const int q4 = (lane & 15) >> 2, p4 = lane & 3, g1 = (lane >> 4) & 1;
  char* ws = P.ws;

  const bf16_t* qptr[NQT]; bf16_t* optr[NQT];
  int ntiles = 0;
  float sc2;
  const bf16_t* gbase; unsigned loff[NCH]; int ldst[NCH]; bool lval[NCH];
  size_t tile_stride = 0;
  int tok_ctx0 = 0, tok_lat0 = 0;
  int ldp = 0;
  int na_r = 0, na_rs = 0, na_rlo = 0, na_qc = 0; bool plain = false;
  int swa_j = 0, swa_tlo = 0;
  float m_init = 0.f, l_init = 0.f;

  if (MODE == 0) {
    sc2 = 0.10206207261596575f * LOG2E;
    int b, head, token;
    if (item < 1024) { b = item >> 8; head = item & 7; token = b * SEQ + ((item & 255) >> 3) * 256 + w * 32 + c; ntiles = 4 + SEQ / 64; }
    else { const int ci = item - 1024; b = ci >> 3; head = ci & 7; token = T_LAT + b * NCTX + 32 * w + c; ntiles = 4; }
    qptr[0] = (const bf16_t*)(ws + QMLA_OFF) + ((size_t)token * 8 + head) * 96;
    optr[0] = (bf16_t*)(ws + ATTO_OFF) + (size_t)token * 1024 + head * 64;
    gbase = (const bf16_t*)(ws + KVF_OFF) + (size_t)(b * 8 + head) * NKEY * 160;
    tile_stride = 64 * 160;
#pragma unroll
    for (int jj = 0; jj < NCH; ++jj) {
      const int n = tid + 512 * jj, row = n / 20, ck = n - row * 20;
      lval[jj] = n < 1280; loff[jj] = (n < 1280 ? n : n - 512) * 8;
      ldst[jj] = (ck < 12) ? (row * C::KS + ck * 16) : (C::VOFF + row * C::VS + (ck - 12) * 16);
    }
  } else if (MODE == 1) {
    sc2 = 0.125f * LOG2E;
    const bf16_t* p0 = (const bf16_t*)(ws + S_OFF);
    int b, head, token;
    if (item < 1024) {
      b = item >> 8; head = (item >> 5) & 7; const int r0 = (item & 31) * 4;
      na_r = r0 + (w >> 1); na_qc = 32 * (w & 1) + c; token = b * SEQ + na_r * 64 + na_qc;
      na_rlo = clampi(r0 - 4, 0, 120); const int rhi = clampi(r0 - 1, 0, 120) + 7;
      na_rs = clampi(na_r - 4, 0, 120); ntiles = 4 + rhi - na_rlo + 1;
      tok_lat0 = b * SEQ + na_rlo * 64;
    } else { const int ci = item - 1024; b = ci >> 3; head = ci & 7; token = T_LAT + b * NCTX + 32 * w + c; ntiles = 4; plain = true; }
    tok_ctx0 = T_LAT + b * NCTX; ldp = 2048;
    qptr[0] = p0 + (size_t)token * 2048 + 416 + head * 64;
    optr[0] = (bf16_t*)(ws + ATTO_OFF) + (size_t)token * 1024 + 512 + head * 64;
    const int row = tid >> 3, ck = tid & 7;
    gbase = p0 + 416 + 512 + head * 64;
    loff[0] = row * 2048 + ck * 8; ldst[0] = row * C::KS + ck * 16; lval[0] = true;
    loff[1] = loff[0] + 512; ldst[1] = C::VOFF + row * C::VS + ck * 16; lval[1] = true;
    if (tid < 465) ((float*)(smem + ATT_BIAS_OFF))[tid] = P.rel_bias[head * 465 + tid] * LOG2E;
  } else {
    sc2 = 0.125f * LOG2E;
    const bf16_t* p1 = (const bf16_t*)(ws + S_OFF);
    const int b = item >> 9, kvh = item & 1; swa_j = (item & 511) >> 1;
    const int hq = kvh * 8 + w;
    {
      const int token = b * SEQ + 32 * swa_j + c;
      qptr[0] = p1 + (size_t)token * 1280 + hq * 64;
      optr[0] = (bf16_t*)(ws + O1_OFF) + (size_t)token * 1024 + hq * 64;
    }
    swa_tlo = max(0, (32 * swa_j - 128) >> 6); const int thi = min(127, (32 * swa_j + 159) >> 6);
    ntiles = 4 + thi - swa_tlo + 1;
    tok_ctx0 = T_LAT + b * NCTX; tok_lat0 = b * SEQ + swa_tlo * 64; ldp = 1280;
    const int row = tid >> 3, ck = tid & 7;
    gbase = p1 + 1024 + kvh * 64;
    loff[0] = row * 1280 + ck * 8; ldst[0] = row * C::KS + ck * 16; lval[0] = true;
    loff[1] = loff[0] + 128; ldst[1] = C::VOFF + row * C::VS + ck * 16; lval[1] = true;
    m_init = P.sinks[hq] * LOG2E; l_init = hh ? 0.f : 1.f;
  }

  auto tile_off = [&](int t) -> size_t {
    if (MODE == 0) return (size_t)t * tile_stride;
    const int tok = (t < 4) ? (tok_ctx0 + 64 * t) : (tok_lat0 + 64 * (t - 4));
    return (size_t)tok * ldp;
  };

  bf16x8 qf[NQT][KST];
#pragma unroll
  for (int qt = 0; qt < NQT; ++qt)
#pragma unroll
    for (int ks = 0; ks < KST; ++ks) qf[qt][ks] = *(const bf16x8*)(qptr[qt] + 16 * ks + 8 * hh);

  f32x16 o[NQT][VT];
  f32x16 nm[NQT];
  float mrun[NQT], lrun[NQT];
#pragma unroll
  for (int qt = 0; qt < NQT; ++qt) {
    mrun[qt] = m_init; lrun[qt] = l_init;
#pragma unroll
    for (int i = 0; i < 16; ++i) nm[qt][i] = -m_init;
#pragma unroll
    for (int vt = 0; vt < VT; ++vt)
#pragma unroll
      for (int i = 0; i < 16; ++i) o[qt][vt][i] = 0.f;
  }

  u32x4 stg0[NCH], stg1[NCH], stg2[NCH];
  {
    const size_t off = tile_off(0);
#pragma unroll
    for (int jj = 0; jj < NCH; ++jj) stg2[jj] = *(const u32x4*)(gbase + off + loff[jj]);
    {
      const size_t off1 = tile_off(min(1, ntiles - 1));
#pragma unroll
      for (int jj = 0; jj < NCH; ++jj) stg0[jj] = *(const u32x4*)(gbase + off1 + loff[jj]);
    }
    {
      const size_t off2 = tile_off(min(2, ntiles - 1));
#pragma unroll
      for (int jj = 0; jj < NCH; ++jj) stg1[jj] = *(const u32x4*)(gbase + off2 + loff[jj]);
    }
#pragma unroll
    for (int jj = 0; jj < NCH; ++jj) if (lval[jj]) *(u32x4*)(smem + ldst[jj]) = stg2[jj];
  }
  __syncthreads();

  const bool grpB = (w >= 4);
  const int sh = grpB ? 0 : 1;
  bf16x8 pf[NQT][2][2];
  f32x16 s[NQT][2];
  bool pf_ok = false, s_ok = false;
#define SB_ __builtin_amdgcn_sched_barrier(0)
  constexpr int CH = KST / 2;

  auto tile_active = [&](int ti) -> bool {
    bool a = (ti >= 0) && (ti < ntiles);
    if (MODE == 1 && !plain && ti >= 4) { const int R = na_rlo + (ti - 4); a = a && (R >= na_rs) && (R < na_rs + 8); }
    return a;
  };
  auto do_pv = [&](const char* vbuf) {
    s16x4 va[2][VT][2];
    const char* vb0 = vbuf + C::VOFF + (4 * hh + q4) * C::VS + (16 * g1 + 4 * p4) * 2;
#pragma unroll
    for (int vt = 0; vt < VT; ++vt) {
      va[0][vt][0] = __builtin_amdgcn_ds_read_tr16_b64_v4i16((LAS s16x4*)(vb0 + 64 * vt));
      va[0][vt][1] = __builtin_amdgcn_ds_read_tr16_b64_v4i16((LAS s16x4*)(vb0 + 64 * vt + 8 * C::VS));
    }
#pragma unroll
    for (int g = 0; g < 4; ++g) {
      if (g + 1 < 4) {
#pragma unroll
        for (int vt = 0; vt < VT; ++vt) {
          va[(g + 1) & 1][vt][0] = __builtin_amdgcn_ds_read_tr16_b64_v4i16((LAS s16x4*)(vb0 + 16 * (g + 1) * C::VS + 64 * vt));
          va[(g + 1) & 1][vt][1] = __builtin_amdgcn_ds_read_tr16_b64_v4i16((LAS s16x4*)(vb0 + (16 * (g + 1) + 8) * C::VS + 64 * vt));
        }
      }
      SB_;
#pragma unroll
      for (int vt = 0; vt < VT; ++vt) {
        const bf16x8 vfrag = __builtin_shufflevector(va[g & 1][vt][0], va[g & 1][vt][1], 0, 1, 2, 3, 4, 5, 6, 7);
#pragma unroll
        for (int qt = 0; qt < NQT; ++qt) o[qt][vt] = __builtin_amdgcn_mfma_f32_32x32x16_bf16(vfrag, pf[qt][g >> 1][g & 1], o[qt][vt], 0, 0, 0);
      }
      SB_;
    }
  };
  auto do_s = [&](const char* kbuf) {
    bf16x8 ka[2][CH];
    const char* kb0 = kbuf + c * C::KS + (8 * hh) * 2;
#pragma unroll
    for (int k = 0; k < CH; ++k) ka[0][k] = *(const bf16x8*)(kb0 + 32 * k);
#pragma unroll
    for (int j = 0; j < 4; ++j) {
      if (j + 1 < 4) {
#pragma unroll
        for (int k = 0; k < CH; ++k) ka[(j + 1) & 1][k] = *(const bf16x8*)(kb0 + 32 * ((j + 1) >> 1) * C::KS + 32 * (((j + 1) & 1) * CH + k));
      }
      SB_;
#pragma unroll
      for (int k = 0; k < CH; ++k)
#pragma unroll
        for (int qt = 0; qt < NQT; ++qt)
          s[qt][j >> 1] = __builtin_amdgcn_mfma_f32_32x32x16_bf16(ka[j & 1][k], qf[qt][(j & 1) * CH + k], (k == 0 && (j & 1) == 0) ? nm[qt] : s[qt][j >> 1], 0, 0, 0);
      SB_;
    }
  };
  auto do_sm = [&](int ti) {
    const int na_dr = na_rlo + (ti - 4) - na_r + 7;
#pragma unroll
    for (int qt = 0; qt < NQT; ++qt) {
      if (MODE == 1 && !plain && ti >= 4) {
        const int qs = clampi(na_qc - 8, 0, 48);
        const float* bb = (const float*)(smem + ATT_BIAS_OFF) + (na_dr * 31 + 15 - na_qc);
#pragma unroll
        for (int mt = 0; mt < 2; ++mt)
#pragma unroll
          for (int i = 0; i < 16; ++i) {
            const int kidx = 32 * mt + crow(i, hh);
            const bool ok = (unsigned)(kidx - qs) < 16u;
            s[qt][mt][i] = ok ? s[qt][mt][i] + bb[kidx] : -1e30f;
          }
      }
      if (MODE == 2 && ti >= 4) {
        const int dbase = 64 * (swa_tlo + ti - 4) - (32 * swa_j + c) + 128;
#pragma unroll
        for (int mt = 0; mt < 2; ++mt)
#pragma unroll
          for (int i = 0; i < 16; ++i) {
            const int kidx = 32 * mt + crow(i, hh);
            const bool ok = (unsigned)(dbase + kidx) <= 256u;
            s[qt][mt][i] = ok ? s[qt][mt][i] : -1e30f;
          }
      }
      float ls = 0.f;
#pragma unroll
      for (int mt = 0; mt < 2; ++mt) {
        float p[16];
#pragma unroll
        for (int i = 0; i < 16; ++i) { p[i] = __builtin_amdgcn_exp2f(s[qt][mt][i]); ls += p[i]; }
#pragma unroll
        for (int sp = 0; sp < 2; ++sp) {
          u32x4 pk = {pk2(p[8 * sp], p[8 * sp + 1]), pk2(p[8 * sp + 2], p[8 * sp + 3]), pk2(p[8 * sp + 4], p[8 * sp + 5]), pk2(p[8 * sp + 6], p[8 * sp + 7])};
          pf[qt][mt][sp] = __builtin_bit_cast(bf16x8, pk);
        }
      }
      const bool force = (MODE != 2) && (ti == 0);
      if (force || __any(!(ls < 1.0e18f))) {
        float mx = -1e30f;
#pragma unroll
        for (int mt = 0; mt < 2; ++mt)
#pragma unroll
          for (int i = 0; i < 16; ++i) mx = fmaxf(mx, s[qt][mt][i]);
        mx = fmaxf(mx, __shfl_xor(mx, 32));
        const float mraw = mx + mrun[qt];
        const float mnew = force ? mraw : fmaxf(mrun[qt], mraw);
        const float delta = mnew - mrun[qt];
        const float alpha = force ? 0.f : __builtin_amdgcn_exp2f(-delta);
        mrun[qt] = mnew;
        lrun[qt] *= alpha;
#pragma unroll
        for (int vt = 0; vt < VT; ++vt)
#pragma unroll
          for (int i = 0; i < 16; ++i) o[qt][vt][i] *= alpha;
#pragma unroll
        for (int i = 0; i < 16; ++i) nm[qt][i] = -mnew;
        ls = 0.f;
#pragma unroll
        for (int mt = 0; mt < 2; ++mt) {
          float p[16];
#pragma unroll
          for (int i = 0; i < 16; ++i) { p[i] = __builtin_amdgcn_exp2f(s[qt][mt][i] - delta); ls += p[i]; }
#pragma unroll
          for (int sp = 0; sp < 2; ++sp) {
            u32x4 pk = {pk2(p[8 * sp], p[8 * sp + 1]), pk2(p[8 * sp + 2], p[8 * sp + 3]), pk2(p[8 * sp + 4], p[8 * sp + 5]), pk2(p[8 * sp + 6], p[8 * sp + 7])};
            pf[qt][mt][sp] = __builtin_bit_cast(bf16x8, pk);
          }
        }
      }
      lrun[qt] += ls;
    }
  };

  auto step = [&](int t, u32x4 (&sl)[NCH], u32x4 (&ss)[NCH]) {
    const int tt = t + sh;
    const char* cur = smem + (tt & 3) * ABUF;
    const char* prv = smem + ((tt - 1) & 3) * ABUF;
    char* nxt = smem + ((t + 2) & 3) * ABUF;
    {
      const size_t off = tile_off(min(t + 4, ntiles - 1));
#pragma unroll
      for (int jj = 0; jj < NCH; ++jj) sl[jj] = *(const u32x4*)(gbase + off + loff[jj]);
    }
    const bool active = tile_active(tt);
    if (!grpB) {
      if (pf_ok) do_pv(prv);
      pf_ok = active;
      if (active) { do_s(cur); do_sm(tt); }
    } else {
      if (s_ok) { do_sm(tt - 1); do_pv(prv); }
      s_ok = active;
      if (active) do_s(cur);
    }
    if (t + 2 < ntiles) {
#pragma unroll
      for (int jj = 0; jj < NCH; ++jj) if (lval[jj]) *(u32x4*)(nxt + ldst[jj]) = ss[jj];
    }
    __syncthreads();
  };
  for (int t = -1; t <= ntiles; t += 3) { step(t, stg2, stg0); step(t + 1, stg0, stg1); step(t + 2, stg1, stg2); }
#pragma unroll
  for (int qt = 0; qt < NQT; ++qt) {
    const float lt = lrun[qt] + __shfl_xor(lrun[qt], 32);
    const float inv = 1.f / lt;
#pragma unroll
    for (int vt = 0; vt < VT; ++vt)
#pragma unroll
      for (int g = 0; g < 4; ++g) {
        const f32x16& ov = o[qt][vt];
        *(u32x2*)(optr[qt] + 32 * vt + 8 * g + 4 * hh) =
            (u32x2){pk2(ov[4 * g] * inv, ov[4 * g + 1] * inv), pk2(ov[4 * g + 2] * inv, ov[4 * g + 3] * inv)};
      }
  }
}

constexpr int NPHASE = 18;
#ifndef REP_ATT
#define REP_ATT 1
#endif
#ifndef REP_GEMM
#define REP_GEMM 1
#endif
constexpr int LDS_BYTES = GEMM_LDS;
#define XB_TMO      128
#define XB_XCNT(j)  (256  + 64 * (j))
#define XB_XSUB(j)  (1280 + 64 * (j))
#define XB_XGEN(j)  (2304 + 64 * (j))
#define XB_TOP      3328
#define XB_TOPGEN   3392
#define XB_SPIN_CAP (1u << 21)
DI unsigned xb_ld(unsigned* p) { return __hip_atomic_load(p, __ATOMIC_RELAXED, __HIP_MEMORY_SCOPE_AGENT); }
DI unsigned xb_add(unsigned* p, unsigned v) { return __hip_atomic_fetch_add(p, v, __ATOMIC_RELAXED, __HIP_MEMORY_SCOPE_AGENT); }
DI unsigned xb_xcc_id() { return (unsigned)__builtin_amdgcn_s_getreg((3 << 11) | 20) & 0xFu; }
#define XB_SPIN(cond, bar) do { unsigned _sp = 0; while (cond) { __builtin_amdgcn_s_sleep(1); \
    if ((++_sp & 255u) == 0u) { if (xb_ld(&(bar)[XB_TMO])) break; if (_sp > XB_SPIN_CAP) { atomicAdd(&(bar)[XB_TMO], 1u); break; } } } } while (0)
DI void xcd_barrier_complete(unsigned* bar, unsigned x, unsigned G, unsigned& nloc, unsigned& nx) {
  unsigned sum, cnt, mine, sp = 0u;
  for (;;) {
    sum = 0u; cnt = 0u; mine = 0u;
#pragma unroll
    for (unsigned j = 0; j < 16; ++j) { const unsigned c = xb_ld(&bar[XB_XCNT(j)]); sum += c; cnt += (c > 0u) ? 1u : 0u; mine = (j == x) ? c : mine; }
    if (sum == G) break;
    __builtin_amdgcn_s_sleep(1);
    if ((++sp & 255u) == 0u) { if (xb_ld(&bar[XB_TMO])) break; if (sp > XB_SPIN_CAP) { atomicAdd(&bar[XB_TMO], 1u); break; } }
  }
  nloc = mine > 0u ? mine : 1u; nx = cnt > 0u ? cnt : 1u;
}
DI void grid_barrier(unsigned* bar, volatile LAS unsigned* st, const unsigned x, const int wid0) {
  PHASE_IDS;
  asm volatile("s_waitcnt vmcnt(0)" ::: "memory");
  __syncthreads();
  if (tid == 0) {
    __builtin_amdgcn_s_waitcnt(0);
    unsigned nloc = st[0], nx = st[1];
    if (nloc == 0u) { xcd_barrier_complete(bar, x, (unsigned)nb, nloc, nx); st[0] = nloc; st[1] = nx; }
    const unsigned old = xb_add(&bar[XB_XSUB(x)], 1u);
    const unsigned gen = old / nloc;
    if (old + 1u == (gen + 1u) * nloc) {
      __builtin_amdgcn_fence(__ATOMIC_RELEASE, "agent");
      asm volatile("s_waitcnt vmcnt(0)" ::: "memory");
      const unsigned og = xb_add(&bar[XB_TOP], 1u);
      const unsigned tg = og / nx;
      if (og + 1u == (tg + 1u) * nx) xb_add(&bar[XB_TOPGEN], 1u);
      else XB_SPIN(xb_ld(&bar[XB_TOPGEN]) == tg, bar);
      __builtin_amdgcn_fence(__ATOMIC_ACQUIRE, "agent");
      xb_add(&bar[XB_XGEN(x)], 1u);
      asm volatile("s_waitcnt vmcnt(0)" ::: "memory");
    } else {
      XB_SPIN(xb_ld(&bar[XB_XGEN(x)]) == gen, bar);
      __builtin_amdgcn_fence(__ATOMIC_ACQUIRE, "agent");
      asm volatile("s_waitcnt vmcnt(0)" ::: "memory");
    }
  }
  __syncthreads();
}

__global__ void __launch_bounds__(512) fwd_megakernel(Params P_unused, int ph_lo, int ph_hi) {
  extern __shared__ __attribute__((aligned(16))) char smem[];
  cg::grid_group grid = cg::this_grid();
  typedef const __attribute__((address_space(4))) Params* KP;
  LAS unsigned char* ldsp = (LAS unsigned char*)smem;
  const int wid0 = __builtin_amdgcn_readfirstlane((int)threadIdx.x >> 6);
  __shared__ uint4 xb_words;
  volatile LAS unsigned* xb_st = (volatile LAS unsigned*)&xb_words;
  const unsigned xb_x = xb_xcc_id();
  if (threadIdx.x == 0) {
    xb_words = make_uint4(0u, 0u, 0u, 0u);
    KP kp0 = (KP)__builtin_amdgcn_kernarg_segment_ptr();
    (void)xb_add(&((unsigned*)(kp0->ws + MISC_BAR))[XB_XCNT(xb_x)], 1u);
  }
  __syncthreads();
  if (ph_hi > 1000) grid.sync();
#define PH_BEGIN KP kp_ = (KP)__builtin_amdgcn_kernarg_segment_ptr(); asm volatile("" : "+s"(kp_)); const Params& P = *(const Params*)kp_; \
  char* ws = P.ws; const float* modv = (const float*)(ws + MISC_MODV); float* h = (float*)(ws + H_OFF); \
  bf16_t* abuf = (bf16_t*)(ws + A_OFF); bf16_t* sbuf = (bf16_t*)(ws + S_OFF); (void)modv; (void)h; (void)abuf; (void)sbuf;
  if (ph_lo <= 0 && 0 < ph_hi) {
    PH_BEGIN
    prep_phase(P, smem, wid0);
    if (0 + 1 < ph_hi) grid_barrier((unsigned*)(ws + MISC_BAR), xb_st, xb_x, wid0);
  }
  if (ph_lo <= 1 && 1 < ph_hi) {
    PH_BEGIN
    norm_phase(P.x, P.ctx, modv, 0, 1024, abuf, T_ALL, wid0);
    if (1 + 1 < ph_hi) grid_barrier((unsigned*)(ws + MISC_BAR), xb_st, xb_x, wid0);
  }
  if (ph_lo <= 2 && 2 < ph_hi) {
    PH_BEGIN
    for (int rep_ = 0; rep_ < REP_GEMM; ++rep_) { __syncthreads(); EpiArgs e{}; e.out = sbuf; e.ldo = 2048; e.qscale = 0.125f * LOG2E; e.qs_lo = 416; e.qs_hi = 928; gemm_phase<EPI_BF16>(abuf, (const bf16_t*)(ws + W_IN0), T_ALL, 2048, 1024, e, ldsp, wid0); }
    if (2 + 1 < ph_hi) grid_barrier((unsigned*)(ws + MISC_BAR), xb_st, xb_x, wid0);
  }
  if (ph_lo <= 3 && 3 < ph_hi) {
    PH_BEGIN
    mla_prep_phase(P, wid0);
    if (3 + 1 < ph_hi) grid_barrier((unsigned*)(ws + MISC_BAR), xb_st, xb_x, wid0);
  }
  if (ph_lo <= 4 && 4 < ph_hi) {
    PH_BEGIN
    { EpiArgs e{}; e.out = ws + QMLA_OFF; e.ldo = 768; e.rope = (const float*)(ws + MISC_ROPEM); e.qscale = 0.10206207261596575f * LOG2E; e.qs_lo = 0; e.qs_hi = 768;
      gemm_phase<EPI_ROPE_MLA>((const bf16_t*)(ws + QN_OFF), (const bf16_t*)(ws + W_Q), T_ALL, 768, 256, e, ldsp, wid0);
      EpiArgs e2{}; e2.out = ws + KVF_OFF; e2.ldo = 1280; __syncthreads();
      gemm_phase<EPI_KVF>((const bf16_t*)(ws + A2_OFF), (const bf16_t*)(ws + W_KV), T_ALL, 1280, 256, e2, ldsp, wid0); }
    if (4 + 1 < ph_hi) grid_barrier((unsigned*)(ws + MISC_BAR), xb_st, xb_x, wid0);
  }
  if (ph_lo <= 5 && 5 < ph_hi) {
    PH_BEGIN
    PHASE_IDS;
    for (int rep_ = 0; rep_ < REP_ATT; ++rep_)
    {
      for (int it = bid; it < 1056; it += nb) attn_item<0>(P, it, smem, tid);
      asm volatile("" ::: "memory");
      for (int it = bid; it < 1056; it += nb) attn_item<1>(P, it, smem, opq_v(tid));
    }
    if (5 + 1 < ph_hi) grid_barrier((unsigned*)(ws + MISC_BAR), xb_st, xb_x, wid0);
  }
  if (ph_lo <= 6 && 6 < ph_hi) {
    PH_BEGIN
    for (int rep_ = 0; rep_ < REP_GEMM; ++rep_) { __syncthreads(); EpiArgs e{}; e.out = h; e.hin_lat = P.x; e.hin_ctx = P.ctx; e.gate = modv + 2048;
                gemm_phase<EPI_RESID>((const bf16_t*)(ws + ATTO_OFF), (const bf16_t*)(ws + W_OUT0), T_LAT, 1024, 1024, e, ldsp, wid0);
                EpiArgs e2{}; e2.out = ws + PART_OFF; __syncthreads();
                gemm_phase<EPI_F32P>((const bf16_t*)(ws + ATTO_OFF) + (size_t)T_LAT * 1024, (const bf16_t*)(ws + W_OUT0), T_CTX, 1024, 1024, e2, ldsp, wid0, 4); }
    if (6 + 1 < ph_hi) grid_barrier((unsigned*)(ws + MISC_BAR), xb_st, xb_x, wid0);
  }
  if (ph_lo <= 7 && 7 < ph_hi) {
    PH_BEGIN
    norm_phase(h, P.ctx, modv, 3072, 4096, abuf, T_ALL, wid0, (const float*)(ws + PART_OFF), 4, modv + 2048, h + (size_t)T_LAT * DM);
    if (7 + 1 < ph_hi) grid_barrier((unsigned*)(ws + MISC_BAR), xb_st, xb_x, wid0);
  }
  if (ph_lo <= 8 && 8 < ph_hi) {
    PH_BEGIN
    for (int rep_ = 0; rep_ < REP_GEMM; ++rep_) { __syncthreads(); EpiArgs e{}; e.out = sbuf; e.ldo = DFF; gemm_phase<EPI_SWIGLU>(abuf, (const bf16_t*)(ws + W_GU0), T_ALL, 2 * DFF, 1024, e, ldsp, wid0); }
    if (8 + 1 < ph_hi) grid_barrier((unsigned*)(ws + MISC_BAR), xb_st, xb_x, wid0);
  }
  if (ph_lo <= 9 && 9 < ph_hi) {
    PH_BEGIN
    { EpiArgs e{}; e.out = h; e.hin_lat = h; e.hin_ctx = h + (size_t)T_LAT * DM; e.gate = modv + 5120;
                gemm_phase<EPI_RESID>(sbuf, (const bf16_t*)(ws + W_DN0), T_LAT, 1024, DFF, e, ldsp, wid0);
                EpiArgs e2{}; e2.out = ws + PART_OFF; __syncthreads();
                gemm_phase<EPI_F32P>(sbuf + (size_t)T_LAT * DFF, (const bf16_t*)(ws + W_DN0), T_CTX, 1024, DFF, e2, ldsp, wid0, 11); }
    if (9 + 1 < ph_hi) grid_barrier((unsigned*)(ws + MISC_BAR), xb_st, xb_x, wid0);
  }
  if (ph_lo <= 10 && 10 < ph_hi) {
    PH_BEGIN
    norm_phase(h, h + (size_t)T_LAT * DM, modv + 5 * 6144, 0, 1024, abuf, T_ALL, wid0, (const float*)(ws + PART_OFF), 11, modv + 5120, h + (size_t)T_LAT * DM);
    if (10 + 1 < ph_hi) grid_barrier((unsigned*)(ws + MISC_BAR), xb_st, xb_x, wid0);
  }
  if (ph_lo <= 11 && 11 < ph_hi) {
    PH_BEGIN
    for (int rep_ = 0; rep_ < REP_GEMM; ++rep_) { __syncthreads(); EpiArgs e{}; e.out = sbuf; e.ldo = 1280; e.rope = (const float*)(ws + MISC_ROPES); e.qscale = 0.125f * LOG2E; e.qs_lo = 0; e.qs_hi = 1024;
                 gemm_phase<EPI_ROPE_SWA>(abuf, (const bf16_t*)(ws + W_IN1), T_ALL, 1280, 1024, e, ldsp, wid0); }
    if (11 + 1 < ph_hi) grid_barrier((unsigned*)(ws + MISC_BAR), xb_st, xb_x, wid0);
  }
  if (ph_lo <= 12 && 12 < ph_hi) {
    PH_BEGIN
    PHASE_IDS;
    for (int it = bid; it < 2048; it += nb) attn_item<2>(P, it, smem, tid);
    if (12 + 1 < ph_hi) grid_barrier((unsigned*)(ws + MISC_BAR), xb_st, xb_x, wid0);
  }
  if (ph_lo <= 13 && 13 < ph_hi) {
    PH_BEGIN
    { EpiArgs e{}; e.out = ws + D13_OFF; e.ldo = 1024;
                 gemm_phase<EPI_BF16>((const bf16_t*)(ws + O1_OFF), (const bf16_t*)(ws + W_OUT1), T_LAT, 1024, 1024, e, ldsp, wid0); }
    if (13 + 1 < ph_hi) grid_barrier((unsigned*)(ws + MISC_BAR), xb_st, xb_x, wid0);
  }
  if (ph_lo <= 14 && 14 < ph_hi) {
    PH_BEGIN
    norm_phase(h, h + (size_t)T_LAT * DM, modv + 5 * 6144, 3072, 4096, abuf, T_LAT, wid0, nullptr, 0, nullptr, nullptr, (const bf16_t*)(ws + D13_OFF), modv + 5 * 6144 + 2048);
    if (14 + 1 < ph_hi) grid_barrier((unsigned*)(ws + MISC_BAR), xb_st, xb_x, wid0);
  }
  if (ph_lo <= 15 && 15 < ph_hi) {
    PH_BEGIN
    for (int rep_ = 0; rep_ < REP_GEMM; ++rep_) { __syncthreads(); EpiArgs e{}; e.out = ws + G1_OFF; e.ldo = DFF; gemm_phase<EPI_SWIGLU>(abuf, (const bf16_t*)(ws + W_GU1), T_LAT, 2 * DFF, 1024, e, ldsp, wid0); }
    if (15 + 1 < ph_hi) grid_barrier((unsigned*)(ws + MISC_BAR), xb_st, xb_x, wid0);
  }
  if (ph_lo <= 16 && 16 < ph_hi) {
    PH_BEGIN
    { EpiArgs e{}; e.out = abuf; e.ldo = 1024;
                 gemm_phase<EPI_BF16>((const bf16_t*)(ws + G1_OFF), (const bf16_t*)(ws + W_DN1), T_LAT, 1024, DFF, e, ldsp, wid0); }
    if (16 + 1 < ph_hi) grid_barrier((unsigned*)(ws + MISC_BAR), xb_st, xb_x, wid0);
  }
  if (ph_lo <= 17 && 17 < ph_hi) {
    PH_BEGIN
    final_norm_phase(h, abuf, modv + 5 * 6144 + 5120, (const bf16_t*)(ws + D13_OFF), modv + 5 * 6144 + 2048, P.final_norm, P.out, wid0);
    if (17 + 1 < ph_hi) grid_barrier((unsigned*)(ws + MISC_BAR), xb_st, xb_x, wid0);
  }
}

extern "C" void kernel_launch(void* const* d_in, const int* in_sizes, int n_in, void* d_out, int out_size, void* d_ws, size_t ws_size,
                              hipStream_t stream) {
  static int grid_blocks = 0;
  if (grid_blocks == 0) {
    if (n_in != 20 || ws_size < WS_END) { fprintf(stderr, "kernel_launch: unexpected n_in %d / ws_size %zu (need %zu)\n", n_in, ws_size, (size_t)WS_END); grid_blocks = -1; return; }
    int dev = 0, cus = 0, per_cu = 0;
    hipGetDevice(&dev);
    hipDeviceGetAttribute(&cus, hipDeviceAttributeMultiprocessorCount, dev);
    hipFuncSetAttribute((const void*)fwd_megakernel, hipFuncAttributeMaxDynamicSharedMemorySize, LDS_BYTES);
    hipOccupancyMaxActiveBlocksPerMultiprocessor(&per_cu, (const void*)fwd_megakernel, 512, LDS_BYTES);
    if (per_cu < 1) { fprintf(stderr, "kernel_launch: occupancy query says %d blocks per CU\n", per_cu); per_cu = 1; }
    grid_blocks = cus;
    (void)hipGetLastError();
  }
  if (grid_blocks < 0) return;
  Params p{};
  const float** pp = (const float**)&p;
  for (int i = 0; i < 20; ++i) pp[i] = (const float*)d_in[i];
  p.out = (float*)d_out; p.ws = (char*)d_ws;
  hipMemsetAsync((char*)d_ws + MISC, 0, MiB, stream);
  int lo = 0, hi = NPHASE;
  void* args[] = {&p, &lo, &hi};
  hipError_t e = hipLaunchCooperativeKernel((const void*)fwd_megakernel, dim3(grid_blocks), dim3(512), args, LDS_BYTES, stream);
  if (e != hipSuccess) fprintf(stderr, "cooperative launch failed: %s (grid %d)\n", hipGetErrorString(e), grid_blocks);
}
```
